# Optimizing an MI355X kernel written in HIP

```python
import math
import jax
import jax.numpy as jnp
from jax import lax
import numpy as np

D_MODEL = 1024
BATCH = 8
SEQ = 2048
DEPTH = 2

D_MIX = D_MODEL
GROUP_W = D_MIX // 4
HEAD_DIM = 64
EPS = 1e-6
NEG_INF = -1e30

MLA_HEADS = GROUP_W // HEAD_DIM
MLA_NOPE = 64
MLA_ROPE = 32
MLA_V = GROUP_W // MLA_HEADS
MLA_Q_RANK = GROUP_W
MLA_KV_RANK = GROUP_W // 2
ROPE_THETA = 10000.0
Q_BLOCK = 128

S5_GROUP_CH = 16
S5_GROUPS = GROUP_W // S5_GROUP_CH
S5_STATE = 64
S5_DT_MIN = 1e-3
S5_DT_MAX = 1e-1

DIL_HEADS = GROUP_W // HEAD_DIM
DIL_PAIRS = ((128, 1), (512, 4), (2048, 16))
T5_BUCKETS = 32
T5_MAX_DIST = 2048

DN_HEADS = GROUP_W // HEAD_DIM
DN_DK = HEAD_DIM
DN_DV = HEAD_DIM
DN_CONV = 4
DN_CHUNK = 64
DN_DT_MIN = 1e-3
DN_DT_MAX = 1e-1

FFN_HIDDEN = -(-8 * D_MODEL // (3 * 256)) * 256

IN_SPLITS = (MLA_Q_RANK, MLA_KV_RANK, MLA_ROPE, GROUP_W, 3 * GROUP_W, 3 * GROUP_W, DN_HEADS, DN_HEADS, GROUP_W)
IN_COLS = MLA_Q_RANK + MLA_KV_RANK + MLA_ROPE + 8 * GROUP_W + 2 * DN_HEADS

kernel_name = 'hybrid_parallel_mixer_trunk'


def rms_norm(x, g):
    xf = x.astype(jnp.float32)
    y = xf * lax.rsqrt(jnp.mean(xf * xf, axis=-1, keepdims=True) + EPS)
    return (y * g.astype(jnp.float32)).astype(x.dtype)


def l2_norm(x):
    return x * lax.rsqrt(jnp.sum(x * x, axis=-1, keepdims=True) + EPS)


def split_cols(t, sizes):
    out, start = [], 0
    for s in sizes:
        out.append(t[..., start:start + s])
        start += s
    return out


def apply_rope(x, pos):
    half = x.shape[-1] // 2
    freqs = ROPE_THETA ** (-jnp.arange(half, dtype=jnp.float32) / half)
    ang = pos[:, None] * freqs[None, :]
    cos = jnp.cos(ang)[None, :, None, :]
    sin = jnp.sin(ang)[None, :, None, :]
    xf = x.astype(jnp.float32)
    x1, x2 = xf[..., :half], xf[..., half:]
    return jnp.concatenate([x1 * cos - x2 * sin, x1 * sin + x2 * cos], axis=-1).astype(x.dtype)


def causal_block_attention(q, k, v, scale):
    B, S, H, Dq = q.shape
    nb = S // Q_BLOCK
    qb = q.reshape(B, nb, Q_BLOCK, H, Dq).transpose(1, 0, 2, 3, 4)
    starts = jnp.arange(nb, dtype=jnp.int32) * Q_BLOCK
    kpos = jnp.arange(S, dtype=jnp.int32)

    def block(args):
        q_blk, s0 = args
        logits = jnp.einsum('bqhd,bkhd->bhqk', q_blk, k).astype(jnp.float32) * scale
        qpos = s0 + jnp.arange(Q_BLOCK, dtype=jnp.int32)
        mask = kpos[None, :] <= qpos[:, None]
        logits = jnp.where(mask[None, None], logits, NEG_INF)
        p = jax.nn.softmax(logits, axis=-1).astype(v.dtype)
        return jnp.einsum('bhqk,bkhd->bqhd', p, v)

    out = lax.map(block, (qb, starts))
    return out.transpose(1, 0, 2, 3, 4).reshape(B, S, H, v.shape[-1])


def mla_mixer(c_q, c_kv, k_rope, q_norm, kv_norm, w_uq, w_ukv, qk_q, qk_k):
    B, S, _ = c_q.shape
    H = MLA_HEADS
    dqk = MLA_NOPE + MLA_ROPE
    q = (rms_norm(c_q, q_norm) @ w_uq).reshape(B, S, H, dqk)
    kv = (rms_norm(c_kv, kv_norm) @ w_ukv).reshape(B, S, H, MLA_NOPE + MLA_V)
    k_nope, v = kv[..., :MLA_NOPE], kv[..., MLA_NOPE:]
    k = jnp.concatenate([k_nope, jnp.broadcast_to(k_rope[:, :, None, :], (B, S, H, MLA_ROPE))], axis=-1)
    q = rms_norm(q, qk_q)
    k = rms_norm(k, qk_k)
    pos = jnp.arange(S, dtype=jnp.float32)
    q = jnp.concatenate([q[..., :MLA_NOPE], apply_rope(q[..., MLA_NOPE:], pos)], axis=-1)
    k = jnp.concatenate([k[..., :MLA_NOPE], apply_rope(k[..., MLA_NOPE:], pos)], axis=-1)
    out = causal_block_attention(q, k, v, dqk ** -0.5)
    return out.reshape(B, S, H * MLA_V)


def complex_affine_combine(e1, e2):
    a1r, a1i, b1r, b1i = e1
    a2r, a2i, b2r, b2i = e2
    ar = a1r * a2r - a1i * a2i
    ai = a1r * a2i + a1i * a2r
    br = a2r * b1r - a2i * b1i + b2r
    bi = a2r * b1i + a2i * b1r + b2i
    return ar, ai, br, bi


def s5_mixer(u, lam_re, lam_im, log_dt, b_re, b_im, c_re, c_im, d_skip, w_glu):
    B, S, W = u.shape
    G, CG = S5_GROUPS, S5_GROUP_CH
    f32 = jnp.float32
    uf = u.astype(f32).reshape(B, S, G, CG)
    lr, li = lam_re.astype(f32), lam_im.astype(f32)
    dt = jnp.exp(log_dt.astype(f32))[:, None]
    mag = jnp.exp(lr * dt)
    ar, ai = mag * jnp.cos(li * dt), mag * jnp.sin(li * dt)
    den = lr * lr + li * li
    nr, ni = ar - 1.0, ai
    zr = (nr * lr + ni * li) / den
    zi = (ni * lr - nr * li) / den
    br, bi = b_re.astype(f32), b_im.astype(f32)
    bbr = zr[..., None] * br - zi[..., None] * bi
    bbi = zr[..., None] * bi + zi[..., None] * br
    xr = jnp.einsum('gpc,bsgc->bsgp', bbr, uf)
    xi = jnp.einsum('gpc,bsgc->bsgp', bbi, uf)
    ar_f = jnp.broadcast_to(ar, xr.shape)
    ai_f = jnp.broadcast_to(ai, xr.shape)
    _, _, hr, hi = lax.associative_scan(complex_affine_combine, (ar_f, ai_f, xr, xi), axis=1)
    y = jnp.einsum('gcp,bsgp->bsgc', c_re.astype(f32), hr) - jnp.einsum('gcp,bsgp->bsgc', c_im.astype(f32), hi)
    y = y.reshape(B, S, W) + d_skip.astype(f32) * u.astype(f32)
    y = y.astype(u.dtype)
    val, gate = jnp.split(y @ w_glu, 2, axis=-1)
    return val * jax.nn.sigmoid(gate)


def t5_bucket(dist):
    exact = T5_BUCKETS // 2
    df = jnp.maximum(dist, 1).astype(jnp.float32)
    large = exact + (jnp.log(df / exact) / math.log(T5_MAX_DIST / exact) * (T5_BUCKETS - exact)).astype(jnp.int32)
    large = jnp.minimum(large, T5_BUCKETS - 1)
    return jnp.where(dist < exact, dist, large)


def dilated_branch(q, k, v, bias_table, window, dilation, scale):
    B, S, H, D = q.shape
    span = window // dilation
    L = S // dilation
    nb = -(-L // span)
    Lp = nb * span

    def to_blocks(t):
        t = t.reshape(B, L, dilation, H, D).transpose(0, 2, 1, 3, 4)
        t = jnp.pad(t, ((0, 0), (0, 0), (0, Lp - L), (0, 0), (0, 0)))
        return t.reshape(B, dilation, nb, span, H, D)

    def with_prev(t):
        prev = jnp.pad(t, ((0, 0), (0, 0), (1, 0), (0, 0), (0, 0), (0, 0)))[:, :, :-1]
        return jnp.concatenate([prev, t], axis=3)

    qb = to_blocks(q)
    kk = with_prev(to_blocks(k))
    vv = with_prev(to_blocks(v))
    qi = jnp.arange(span, dtype=jnp.int32)[:, None] + span
    kj = jnp.arange(2 * span, dtype=jnp.int32)[None, :]
    delta = qi - kj
    band = (delta >= 0) & (delta <= span)
    before_start = (jnp.arange(nb)[:, None, None] == 0) & (kj < span)[None]
    valid = band[None] & (~before_start)
    bias = bias_table[t5_bucket(jnp.clip(delta, 0, span) * dilation)]
    bias = bias.transpose(2, 0, 1).astype(jnp.float32)
    logits = jnp.einsum('bgnqhd,bgnkhd->bgnhqk', qb, kk).astype(jnp.float32) * scale + bias
    logits = jnp.where(valid[None, None, :, None], logits, NEG_INF)
    m = jnp.max(logits, axis=-1)
    p = jnp.exp(logits - m[..., None])
    l = jnp.sum(p, axis=-1)
    o = jnp.einsum('bgnhqk,bgnkhd->bgnqhd', p.astype(v.dtype), vv).astype(jnp.float32)

    def from_blocks(t):
        t = t.reshape(B, dilation, Lp, *t.shape[4:])[:, :, :L]
        t = jnp.moveaxis(t, 1, 2)
        return t.reshape(B, S, *t.shape[3:])

    return from_blocks(o), from_blocks(jnp.swapaxes(m, -1, -2)), from_blocks(jnp.swapaxes(l, -1, -2))


def dilated_mixer(qkv, q_norm, k_norm, bias_table):
    B, S, _ = qkv.shape
    q, k, v = [t.reshape(B, S, DIL_HEADS, HEAD_DIM) for t in jnp.split(qkv, 3, axis=-1)]
    q = rms_norm(q, q_norm)
    k = rms_norm(k, k_norm)
    branches = [dilated_branch(q, k, v, bias_table, w, d, HEAD_DIM ** -0.5) for (w, d) in DIL_PAIRS]
    m_all = jnp.stack([br[1] for br in branches])
    l_all = jnp.stack([br[2] for br in branches])
    o_all = jnp.stack([br[0] for br in branches])
    wts = jnp.exp(m_all - jnp.max(m_all, axis=0, keepdims=True))
    num = jnp.sum(wts[..., None] * o_all, axis=0)
    den = jnp.sum(wts * l_all, axis=0)
    return (num / den[..., None]).astype(qkv.dtype).reshape(B, S, DIL_HEADS * HEAD_DIM)


def causal_depthwise_conv(x, w):
    K, C = w.shape
    return lax.conv_general_dilated(x, w[:, None, :].astype(x.dtype), window_strides=(1,),
                                    padding=[(K - 1, 0)], dimension_numbers=('NWC', 'WIO', 'NWC'),
                                    feature_group_count=C)


def chunked_gated_delta(q, k, v, g, beta):
    B, S, H, DK = q.shape
    DV = v.shape[-1]
    C = DN_CHUNK
    N = S // C

    def chunks(t):
        return jnp.moveaxis(t.reshape(B, N, C, H, *t.shape[3:]), 3, 1)

    q, k, v, g, beta = chunks(q), chunks(k), chunks(v), chunks(g), chunks(beta)
    gc = jnp.cumsum(g, axis=-1)
    causal = jnp.tril(jnp.ones((C, C), dtype=bool))
    strict = jnp.tril(jnp.ones((C, C), dtype=bool), -1)
    decay = jnp.exp(jnp.where(causal, gc[..., :, None] - gc[..., None, :], NEG_INF))
    kb = k * beta[..., None]
    lmat = jnp.where(strict, jnp.einsum('bhnid,bhnjd->bhnij', kb, k) * decay, 0.0)
    eye = jnp.eye(C, dtype=jnp.float32)
    rhs = jnp.concatenate([kb * jnp.exp(gc)[..., None], v * beta[..., None]], axis=-1)
    wu = lax.linalg.triangular_solve(eye + lmat, rhs, left_side=True, lower=True, unit_diagonal=True)
    w_c, u_c = wu[..., :DK], wu[..., DK:]
    a_qk = jnp.where(causal, jnp.einsum('bhnid,bhnjd->bhnij', q, k) * decay, 0.0)
    q_dec = q * jnp.exp(gc)[..., None]
    g_last = gc[..., -1]
    k_dec = k * jnp.exp(g_last[..., None] - gc)[..., None]
    xs = tuple(jnp.moveaxis(t, 2, 0) for t in (w_c, u_c, q_dec, a_qk, k_dec, jnp.exp(g_last)))

    def step(state, inp):
        w_i, u_i, q_i, a_i, k_i, d_i = inp
        v_new = u_i - jnp.einsum('bhck,bhkv->bhcv', w_i, state)
        o_i = jnp.einsum('bhck,bhkv->bhcv', q_i, state) + jnp.einsum('bhij,bhjv->bhiv', a_i, v_new)
        state = state * d_i[..., None, None] + jnp.einsum('bhck,bhcv->bhkv', k_i, v_new)
        return state, o_i

    s0 = jnp.zeros((B, H, DK, DV), jnp.float32)
    _, o = lax.scan(step, s0, xs)
    o = jnp.moveaxis(o, 0, 2)
    return jnp.moveaxis(o, 1, 3).reshape(B, S, H, DV)


def gated_delta_mixer(qkv, a, b, gate, conv_w, a_log, dt_bias, o_norm):
    B, S, _ = qkv.shape
    H = DN_HEADS
    f32 = jnp.float32
    qkv_c = jax.nn.silu(causal_depthwise_conv(qkv, conv_w))
    q, k, v = jnp.split(qkv_c, 3, axis=-1)
    q = l2_norm(q.reshape(B, S, H, DN_DK).astype(f32)) * (DN_DK ** -0.5)
    k = l2_norm(k.reshape(B, S, H, DN_DK).astype(f32))
    v = v.reshape(B, S, H, DN_DV).astype(f32)
    beta = jax.nn.sigmoid(b.astype(f32))
    g = -jnp.exp(a_log.astype(f32)) * jax.nn.softplus(a.astype(f32) + dt_bias.astype(f32))
    o = chunked_gated_delta(q, k, v, g, beta)
    o = rms_norm(o, o_norm) * jax.nn.silu(gate.astype(f32).reshape(B, S, H, DN_DV))
    return o.reshape(B, S, H * DN_DV).astype(qkv.dtype)


def setup_inputs(seed: int = 0) -> dict:
    key = jax.random.key(seed)
    ks = iter(jax.random.split(key, 32))
    f32 = jnp.float32
    L = DEPTH

    def nrm(shape, scale):
        return jax.random.normal(next(ks), shape, f32) * scale

    def gain(shape):
        return 1.0 + nrm(shape, 0.02)

    def unif(shape, lo, hi):
        return jax.random.uniform(next(ks), shape, f32, lo, hi)

    G, P, CG = S5_GROUPS, S5_STATE, S5_GROUP_CH
    x = nrm((BATCH, SEQ, D_MODEL), 1.0)
    attn_norm = gain((L, D_MODEL))
    w_in = nrm((L, D_MODEL, IN_COLS), D_MODEL ** -0.5)
    w_out = nrm((L, D_MIX, D_MODEL), D_MIX ** -0.5)
    mla_q_norm = gain((L, MLA_Q_RANK))
    mla_kv_norm = gain((L, MLA_KV_RANK))
    mla_w_uq = nrm((L, MLA_Q_RANK, MLA_HEADS * (MLA_NOPE + MLA_ROPE)), MLA_Q_RANK ** -0.5)
    mla_w_ukv = nrm((L, MLA_KV_RANK, MLA_HEADS * (MLA_NOPE + MLA_V)), MLA_KV_RANK ** -0.5)
    mla_qk_q = gain((L, MLA_NOPE + MLA_ROPE))
    mla_qk_k = gain((L, MLA_NOPE + MLA_ROPE))
    s5_lambda_re = -0.5 * (1.0 + nrm((L, G, P), 0.02))
    s5_lambda_im = jnp.pi * jnp.arange(P, dtype=f32)[None, None, :] + nrm((L, G, P), 0.01)
    s5_log_dt = unif((L, G), math.log(S5_DT_MIN), math.log(S5_DT_MAX))
    s5_b_re = nrm((L, G, P, CG), (2 * CG) ** -0.5)
    s5_b_im = nrm((L, G, P, CG), (2 * CG) ** -0.5)
    s5_c_re = nrm((L, G, CG, P), P ** -0.5)
    s5_c_im = nrm((L, G, CG, P), P ** -0.5)
    s5_d = nrm((L, GROUP_W), 1.0)
    s5_w_glu = nrm((L, GROUP_W, 2 * GROUP_W), GROUP_W ** -0.5)
    dil_q_norm = gain((L, HEAD_DIM))
    dil_k_norm = gain((L, HEAD_DIM))
    t5_bias = nrm((T5_BUCKETS, DIL_HEADS), 0.2)
    dn_conv = nrm((L, DN_CONV, 3 * GROUP_W), DN_CONV ** -0.5)
    dn_a_log = jnp.log(unif((L, DN_HEADS), 1.0, 16.0))
    dt = jnp.exp(unif((L, DN_HEADS), math.log(DN_DT_MIN), math.log(DN_DT_MAX)))
    dn_dt_bias = dt + jnp.log(-jnp.expm1(-dt))
    dn_o_norm = gain((L, DN_DV))
    ffn_norm = gain((L, D_MODEL))
    ffn_w1 = nrm((L, D_MODEL, FFN_HIDDEN), D_MODEL ** -0.5)
    ffn_w3 = nrm((L, D_MODEL, FFN_HIDDEN), D_MODEL ** -0.5)
    ffn_w2 = nrm((L, FFN_HIDDEN, D_MODEL), FFN_HIDDEN ** -0.5)
    return {'x': x, 'attn_norm': attn_norm, 'w_in': w_in, 'w_out': w_out,
            'mla_q_norm': mla_q_norm, 'mla_kv_norm': mla_kv_norm, 'mla_w_uq': mla_w_uq,
            'mla_w_ukv': mla_w_ukv, 'mla_qk_q': mla_qk_q, 'mla_qk_k': mla_qk_k,
            's5_lambda_re': s5_lambda_re, 's5_lambda_im': s5_lambda_im, 's5_log_dt': s5_log_dt,
            's5_b_re': s5_b_re, 's5_b_im': s5_b_im, 's5_c_re': s5_c_re, 's5_c_im': s5_c_im,
            's5_d': s5_d, 's5_w_glu': s5_w_glu, 'dil_q_norm': dil_q_norm, 'dil_k_norm': dil_k_norm,
            't5_bias': t5_bias, 'dn_conv': dn_conv, 'dn_a_log': dn_a_log, 'dn_dt_bias': dn_dt_bias,
            'dn_o_norm': dn_o_norm, 'ffn_norm': ffn_norm, 'ffn_w1': ffn_w1, 'ffn_w3': ffn_w3,
            'ffn_w2': ffn_w2}


def reference(x, attn_norm, w_in, w_out, mla_q_norm, mla_kv_norm, mla_w_uq, mla_w_ukv, mla_qk_q, mla_qk_k,
              s5_lambda_re, s5_lambda_im, s5_log_dt, s5_b_re, s5_b_im, s5_c_re, s5_c_im, s5_d, s5_w_glu,
              dil_q_norm, dil_k_norm, t5_bias, dn_conv, dn_a_log, dn_dt_bias, dn_o_norm,
              ffn_norm, ffn_w1, ffn_w3, ffn_w2):
    h = x
    for l in range(DEPTH):
        n = rms_norm(h, attn_norm[l])
        proj = n @ w_in[l]
        c_q, c_kv, k_rope, u_s5, qkv_dil, qkv_dn, a_dn, b_dn, gate_dn = split_cols(proj, IN_SPLITS)
        y_mla = mla_mixer(c_q, c_kv, k_rope, mla_q_norm[l], mla_kv_norm[l], mla_w_uq[l], mla_w_ukv[l],
                          mla_qk_q[l], mla_qk_k[l])
        y_s5 = s5_mixer(u_s5, s5_lambda_re[l], s5_lambda_im[l], s5_log_dt[l], s5_b_re[l], s5_b_im[l],
                        s5_c_re[l], s5_c_im[l], s5_d[l], s5_w_glu[l])
        y_dil = dilated_mixer(qkv_dil, dil_q_norm[l], dil_k_norm[l], t5_bias)
        y_dn = gated_delta_mixer(qkv_dn, a_dn, b_dn, gate_dn, dn_conv[l], dn_a_log[l], dn_dt_bias[l],
                                 dn_o_norm[l])
        mixed = jnp.concatenate([y_mla, y_s5, y_dil, y_dn], axis=-1)
        h = h + mixed @ w_out[l]
        n = rms_norm(h, ffn_norm[l])
        h = h + (jax.nn.silu(n @ ffn_w1[l]) * (n @ ffn_w3[l])) @ ffn_w2[l]
    return h
```

```cpp
#include <hip/hip_runtime.h>
#include <hip/hip_cooperative_groups.h>
#include <cstdio>
#include <cstdint>
#include <cmath>
#ifndef MK_MODE
#define MK_MODE 2
#endif
#ifndef PH_MASK
#define PH_MASK 0xFFFF
#endif

namespace pg8 {
#define PG8_LAS __attribute__((address_space(3)))
typedef unsigned short bf16_t;
typedef short bf16x8 __attribute__((ext_vector_type(8)));
typedef float f32x4 __attribute__((ext_vector_type(4)));
typedef unsigned u32x4 __attribute__((ext_vector_type(4)));
constexpr int BM = 256, BK = 64, HALF = 128, HTB = HALF * BK * 2  , STAGE_BYTES = 8 * HTB, NXCD = 8, WGM = 8;

__host__ __device__ __forceinline__ int lds_byte(int r, int c) { const int st = (r >> 4) * 2 + (c >> 5), rr = r & 15, cc = c & 31, ob = rr * 64 + cc * 2; return st * 1024 + (ob ^ (((ob >> 9) & 1) << 5)); }
__host__ __device__ __forceinline__ void stage_rc(int b, int& R, int& C) { const int st = b / 1024, sb = b % 1024, swz = sb ^ (((sb >> 9) & 1) << 5); R = (st >> 1) * 16 + swz / 64; C = (st & 1) * 32 + (swz % 64) / 2; }
__host__ __device__ __forceinline__ int perm32(int rho) { const int n = rho >> 4, i = rho & 15; return 8 * (i >> 2) + 4 * n + (i & 3); }

struct Unit { int pm, pn; };
struct Gemm { const bf16_t* A; const bf16_t* Bt; int M, N, K, lda; };

struct StaticOrder {
    int nM, nN, nwg, G, c;
    __host__ __device__ void init(int M, int N, int G_, int c_) { nM = M / BM; nN = N / BM; nwg = nM * nN; G = G_; c = c_; }
    __host__ __device__ bool next(int i, Unit& u) const {
        const long L = (long)i * G + c; if (L >= nwg) return false;
        int wgid = (int)L; { const int q = nwg / NXCD, r = nwg % NXCD, xcd = wgid % NXCD, off = wgid / NXCD; wgid = (xcd < r ? xcd * (q + 1) : r * (q + 1) + (xcd - r) * q) + off; }
        const int nig = WGM * nN, gid = wgid / nig, fm = gid * WGM, gsz = (nM - fm) < WGM ? (nM - fm) : WGM;
        u.pm = fm + ((wgid % nig) % gsz); u.pn = (wgid % nig) / gsz; return true;
    }
    __device__ __forceinline__ void a_ready(const Unit&) const {}
    __device__ __forceinline__ void done(const Unit&) const {}
};

__device__ __forceinline__ unsigned cvt_pk_bf16(float lo, float hi) { unsigned r; asm volatile("v_cvt_pk_bf16_f32 %0, %1, %2" : "=v"(r) : "v"(lo), "v"(hi)); return r; }
__device__ __forceinline__ float row_rs(const float* ssq, int row) {
    const f32x4* p = (const f32x4*)(ssq + (size_t)row * 16); const f32x4 a = p[0], b = p[1], c = p[2], d = p[3];
    const float s = ((a[0] + a[1]) + (a[2] + a[3])) + ((b[0] + b[1]) + (b[2] + b[3])) + ((c[0] + c[1]) + (c[2] + c[3])) + ((d[0] + d[1]) + (d[2] + d[3]));
    return 1.0f / sqrtf(s * (1.0f / 1024.0f) + 1e-6f);
}
struct EpiRowScale {
    static constexpr bool PERM = true, AFTER_DRAIN = false;
    bf16_t* O; int ldc; const float* ssq;
    __device__ __forceinline__ void operator()(const f32x4 (&acc)[2][2][4][2], const Unit& u, int wr, int wc, int fr, int fq) const {
        const int row0 = u.pm * BM + wr * 64 + fr, col0 = u.pn * BM + wc * 32 + 8 * fq;
#pragma unroll
        for (int ai = 0; ai < 2; ++ai)
#pragma unroll
            for (int m = 0; m < 4; ++m) { const int row = row0 + ai * HALF + m * 16; const float rs = row_rs(ssq, row); bf16_t* rowp = O + (size_t)row * ldc + col0;
#pragma unroll
                for (int bj = 0; bj < 2; ++bj) { const f32x4 v0 = acc[ai][bj][m][0] * rs, v1 = acc[ai][bj][m][1] * rs;
                    u32x4 w; w.x = cvt_pk_bf16(v0[0], v0[1]); w.y = cvt_pk_bf16(v0[2], v0[3]); w.z = cvt_pk_bf16(v1[0], v1[1]); w.w = cvt_pk_bf16(v1[2], v1[3]);
                    *(u32x4*)(rowp + bj * HALF) = w; } }
    }
};
template <int mode> struct EpiGated {
    static constexpr bool PERM = true, AFTER_DRAIN = false;
    bf16_t* O; int ldc; const float* ssq;
    __device__ __forceinline__ void operator()(const f32x4 (&acc)[2][2][4][2], const Unit& u, int wr, int wc, int fr, int fq) const {
        const int row0 = u.pm * BM + wr * 64 + fr, col0 = u.pn * HALF + wc * 32 + 8 * fq;
#pragma unroll
        for (int ai = 0; ai < 2; ++ai)
#pragma unroll
            for (int m = 0; m < 4; ++m) { const int row = row0 + ai * HALF + m * 16; const float rs = (mode == 0) ? row_rs(ssq, row) : 1.0f;
                float o[8];
#pragma unroll
                for (int n = 0; n < 2; ++n)
#pragma unroll
                    for (int j = 0; j < 4; ++j) { const float a = acc[ai][0][m][n][j] * rs, b = acc[ai][1][m][n][j] * rs;
                        const float x = (mode == 0) ? a : b; const float sg = 1.0f / (1.0f + __expf(-x));
                        o[n * 4 + j] = (mode == 0) ? (a * sg) * b : a * sg; }
                u32x4 w; w.x = cvt_pk_bf16(o[0], o[1]); w.y = cvt_pk_bf16(o[2], o[3]); w.z = cvt_pk_bf16(o[4], o[5]); w.w = cvt_pk_bf16(o[6], o[7]);
                *(u32x4*)(O + (size_t)row * ldc + col0) = w; }
    }
};
struct EpiResid {
    static constexpr bool PERM = true, AFTER_DRAIN = false;
    const float* hin; float* hout; bf16_t* xb; float* ssq;
    __device__ __forceinline__ void operator()(const f32x4 (&acc)[2][2][4][2], const Unit& u, int wr, int wc, int fr, int fq) const {
        const int row0 = u.pm * BM + wr * 64 + fr, col0 = u.pn * BM + wc * 32 + 8 * fq;
#pragma unroll
        for (int ai = 0; ai < 2; ++ai)
#pragma unroll
            for (int m = 0; m < 4; ++m) { const int row = row0 + ai * HALF + m * 16; const size_t off = (size_t)row * 1024 + col0; float sq = 0.f;
#pragma unroll
                for (int bj = 0; bj < 2; ++bj) {
                    const f32x4 h0 = *(const f32x4*)(hin + off + bj * HALF) + acc[ai][bj][m][0], h1 = *(const f32x4*)(hin + off + bj * HALF + 4) + acc[ai][bj][m][1];
                    *(f32x4*)(hout + off + bj * HALF) = h0; *(f32x4*)(hout + off + bj * HALF + 4) = h1;
                    u32x4 w; w.x = cvt_pk_bf16(h0[0], h0[1]); w.y = cvt_pk_bf16(h0[2], h0[3]); w.z = cvt_pk_bf16(h1[0], h1[1]); w.w = cvt_pk_bf16(h1[2], h1[3]);
                    *(u32x4*)(xb + off + bj * HALF) = w;
                    sq += (h0[0] * h0[0] + h0[1] * h0[1]) + (h0[2] * h0[2] + h0[3] * h0[3]) + (h1[0] * h1[0] + h1[1] * h1[1]) + (h1[2] * h1[2] + h1[3] * h1[3]); }
                sq += __shfl_xor(sq, 16); sq += __shfl_xor(sq, 32);
                if (fq == 0) ssq[(size_t)row * 16 + u.pn * 4 + wc] = sq; }
    }
};

template <class Epi, class Sched, bool ALIGN_EPI = false, bool SP2 = false>
__device__ __forceinline__ void gemm_phase(PG8_LAS unsigned char* lds, const Gemm g, const Sched& S, const Epi& E) {
    int tid_ = threadIdx.x; asm volatile("" : "+v"(tid_)); const int tid = tid_, wid = __builtin_amdgcn_readfirstlane(tid >> 6), lane = tid & 63, wr = wid >> 2, wc = wid & 3, fr = lane & 15, fq = lane >> 4;
    int K_ = g.K; asm volatile("" : "+s"(K_)); const int K = K_, nt = K / BK;
    unsigned voffA[2], voffB[2];
#pragma unroll
    for (int i = 0; i < 2; ++i) { int R, C; stage_rc(tid * 16 + i * 8192, R, C); const int Rb = Epi::PERM ? ((R & ~31) + perm32(R & 31)) : R;
        voffA[i] = (unsigned)(R * g.lda + C) * 2u; voffB[i] = (unsigned)(Rb * K + C) * 2u; }
    const size_t kstep = (size_t)(BK * 2);
    const size_t hstepB = (size_t)HALF * K * 2, hstepA = (size_t)HALF * g.lda * 2;
    const size_t tstepB = 2 * hstepB, tstepA = 2 * hstepA;
    const unsigned ldsw = (unsigned)wid * 1024u;
    const int aoff = lds_byte(wr * 64 + fr, fq * 8), boff = lds_byte(wc * 32 + fr, fq * 8);
#define PG8_SA(b, h) (((b) * 2 + (h)) * HTB)
#define PG8_SB(b, h) ((4 + (b) * 2 + (h)) * HTB)
#define PG8_STAGE(bufoff, gbase, voff) do { _Pragma("unroll") for (int _i = 0; _i < 2; ++_i) \
        __builtin_amdgcn_global_load_lds((const unsigned*)((const char*)(gbase) + (voff)[_i]), (PG8_LAS unsigned*)(lds + (bufoff) + ldsw + _i * 8192), 16, 0, 0); } while (0)
#define PG8_LDA(dst, b, h) do { _Pragma("unroll") for (int m = 0; m < 4; ++m) _Pragma("unroll") for (int k = 0; k < 2; ++k) dst[m][k] = *(const PG8_LAS bf16x8*)(lds + PG8_SA(b, h) + aoff + m * 2048 + k * 1024); } while (0)
#define PG8_LDB(dst, b, h) do { _Pragma("unroll") for (int n = 0; n < 2; ++n) _Pragma("unroll") for (int k = 0; k < 2; ++k) dst[n][k] = *(const PG8_LAS bf16x8*)(lds + PG8_SB(b, h) + boff + n * 2048 + k * 1024); } while (0)
#define PG8_MMA(ai, bj, At, Bt) do { __builtin_amdgcn_s_setprio(1); _Pragma("unroll") for (int m = 0; m < 4; ++m) _Pragma("unroll") for (int n = 0; n < 2; ++n) _Pragma("unroll") for (int k = 0; k < 2; ++k) \
        acc[ai][bj][m][n] = __builtin_amdgcn_mfma_f32_16x16x32_bf16(Bt[n][k], At[m][k], acc[ai][bj][m][n], 0, 0, 0); __builtin_amdgcn_s_setprio(0); } while (0)
#define PG8_WAIT_V(n) asm volatile("s_waitcnt vmcnt(" #n ")" ::: "memory")
#define PG8_WAIT_L(n) asm volatile("s_waitcnt lgkmcnt(" #n ")" ::: "memory")
#define PG8_BAR __builtin_amdgcn_s_barrier()
#define PG8_SCHED __builtin_amdgcn_sched_barrier(0)
    Unit cur, nxt; int ui = 0;
    if (!S.next(0, cur)) return;
    f32x4 acc[2][2][4][2];
#pragma unroll
    for (int a = 0; a < 2; ++a)
#pragma unroll
        for (int b = 0; b < 2; ++b)
#pragma unroll
            for (int m = 0; m < 4; ++m)
#pragma unroll
                for (int n = 0; n < 2; ++n) acc[a][b][m][n] = (f32x4){0.f, 0.f, 0.f, 0.f};
    bf16x8 At[4][2], B0[2][2], B1[2][2];
    const char* cA = (const char*)g.A + (size_t)cur.pm * tstepA; const char* cB = (const char*)g.Bt + (size_t)cur.pn * tstepB;
    S.a_ready(cur);
    if constexpr (SP2) {
        PG8_STAGE(PG8_SB(0, 0), cB, voffB); PG8_STAGE(PG8_SB(0, 1), cB + hstepB, voffB); PG8_STAGE(PG8_SA(0, 0), cA, voffA); PG8_STAGE(PG8_SA(0, 1), cA + hstepA, voffA);
        if (wr == 1) PG8_BAR;
        PG8_WAIT_V(2); PG8_BAR;
        PG8_STAGE(PG8_SB(1, 0), cB + kstep, voffB); PG8_STAGE(PG8_SA(1, 0), cA + kstep, voffA); PG8_STAGE(PG8_SB(1, 1), cB + hstepB + kstep, voffB);
        PG8_WAIT_V(6); PG8_BAR;
    } else {
        PG8_STAGE(PG8_SB(0, 0), cB, voffB); PG8_STAGE(PG8_SA(0, 0), cA, voffA); PG8_STAGE(PG8_SB(0, 1), cB + hstepB, voffB); PG8_STAGE(PG8_SA(0, 1), cA + hstepA, voffA);
        if (wr == 1) PG8_BAR;
        PG8_WAIT_V(4); PG8_BAR;
        PG8_STAGE(PG8_SB(1, 0), cB + kstep, voffB); PG8_STAGE(PG8_SA(1, 0), cA + kstep, voffA); PG8_STAGE(PG8_SB(1, 1), cB + hstepB + kstep, voffB);
        PG8_WAIT_V(6); PG8_BAR;
    }
    for (;;) {
        const bool has_next = S.next(ui + 1, nxt);
        const char* nA = has_next ? (const char*)g.A + (size_t)nxt.pm * tstepA : cA; const char* nB = has_next ? (const char*)g.Bt + (size_t)nxt.pn * tstepB : cB;
        for (int t = 0; t < nt; t += 2) {
            const bool last = (t == nt - 2);
            const char* a1 = cA + (size_t)(t + 1) * kstep;
            const char* a2 = last ? nA : cA + (size_t)(t + 2) * kstep; const char* b2 = last ? nB : cB + (size_t)(t + 2) * kstep;
            const char* a3 = a2 + kstep; const char* b3 = b2 + kstep;
            if (last && has_next) S.a_ready(nxt);
            if constexpr (SP2) {
            PG8_LDB(B0, 0, 0); PG8_LDB(B1, 0, 1); PG8_SCHED; PG8_LDA(At, 0, 0); PG8_STAGE(PG8_SA(1, 1), a1 + hstepA, voffA);
            PG8_WAIT_V(8); PG8_WAIT_L(0); PG8_BAR; PG8_MMA(0, 0, At, B0); PG8_MMA(0, 1, At, B1); PG8_BAR; PG8_SCHED;
            PG8_LDA(At, 0, 1); PG8_STAGE(PG8_SB(0, 0), b2, voffB); PG8_STAGE(PG8_SB(0, 1), b2 + hstepB, voffB); PG8_STAGE(PG8_SA(0, 0), a2, voffA);
            PG8_WAIT_V(8); PG8_WAIT_L(0); PG8_BAR; PG8_MMA(1, 0, At, B0); PG8_MMA(1, 1, At, B1); PG8_BAR; PG8_SCHED;
            PG8_LDB(B0, 1, 0); PG8_LDB(B1, 1, 1); PG8_SCHED; PG8_LDA(At, 1, 0); PG8_STAGE(PG8_SA(0, 1), a2 + hstepA, voffA);
            PG8_WAIT_V(8); PG8_WAIT_L(0); PG8_BAR; PG8_MMA(0, 0, At, B0); PG8_MMA(0, 1, At, B1); PG8_BAR; PG8_SCHED;
            PG8_LDA(At, 1, 1); PG8_STAGE(PG8_SB(1, 0), b3, voffB); PG8_STAGE(PG8_SB(1, 1), b3 + hstepB, voffB); PG8_STAGE(PG8_SA(1, 0), a3, voffA);
            PG8_WAIT_V(8); PG8_WAIT_L(0); PG8_BAR; PG8_MMA(1, 0, At, B0); PG8_MMA(1, 1, At, B1); PG8_BAR; PG8_SCHED;
            } else {
            PG8_LDB(B0, 0, 0); PG8_SCHED; PG8_LDA(At, 0, 0); PG8_STAGE(PG8_SA(1, 1), a1 + hstepA, voffA);
            PG8_WAIT_L(8); PG8_BAR; PG8_WAIT_L(0); PG8_MMA(0, 0, At, B0); PG8_BAR; PG8_SCHED;
            PG8_LDB(B1, 0, 1); PG8_STAGE(PG8_SB(0, 0), b2, voffB);
            PG8_BAR; PG8_WAIT_L(0); PG8_MMA(0, 1, At, B1); PG8_BAR;
            PG8_LDA(At, 0, 1); PG8_STAGE(PG8_SA(0, 0), a2, voffA);
            PG8_BAR; PG8_WAIT_L(0); PG8_MMA(1, 0, At, B0); PG8_BAR; PG8_SCHED;
            PG8_STAGE(PG8_SB(0, 1), b2 + hstepB, voffB);
            PG8_WAIT_V(6); PG8_BAR; PG8_MMA(1, 1, At, B1); PG8_BAR;
            PG8_LDB(B0, 1, 0); PG8_SCHED; PG8_LDA(At, 1, 0); PG8_STAGE(PG8_SA(0, 1), a2 + hstepA, voffA);
            PG8_WAIT_L(8); PG8_BAR; PG8_WAIT_L(0); PG8_MMA(0, 0, At, B0); PG8_BAR; PG8_SCHED;
            PG8_LDB(B1, 1, 1); PG8_STAGE(PG8_SB(1, 0), b3, voffB);
            PG8_BAR; PG8_WAIT_L(0); PG8_MMA(0, 1, At, B1); PG8_BAR;
            PG8_LDA(At, 1, 1); PG8_STAGE(PG8_SA(1, 0), a3, voffA);
            PG8_BAR; PG8_WAIT_L(0); PG8_MMA(1, 0, At, B0); PG8_BAR; PG8_SCHED;
            PG8_STAGE(PG8_SB(1, 1), b3 + hstepB, voffB);
            PG8_WAIT_V(6); PG8_BAR; PG8_MMA(1, 1, At, B1); PG8_BAR;
            }
        }
        if constexpr (ALIGN_EPI) { if (wr == 0) PG8_BAR; }
        if constexpr (!Epi::AFTER_DRAIN) { E(acc, cur, wr, wc, fr, fq); S.done(cur); }
        if (!has_next) break;
#pragma unroll
        for (int a = 0; a < 2; ++a)
#pragma unroll
            for (int b = 0; b < 2; ++b)
#pragma unroll
                for (int m = 0; m < 4; ++m)
#pragma unroll
                    for (int n = 0; n < 2; ++n) acc[a][b][m][n] = (f32x4){0.f, 0.f, 0.f, 0.f};
        cur = nxt; cA = nA; cB = nB; ++ui;
        if constexpr (ALIGN_EPI) { if (wr == 1) PG8_BAR; }
    }
    PG8_WAIT_V(0);
    if constexpr (!ALIGN_EPI) { if (wr == 0) PG8_BAR; }
    PG8_BAR;
    if constexpr (Epi::AFTER_DRAIN) { E.fused(acc, cur, wr, wc, fr, fq, lds, wid, lane); S.done(cur); }
#undef PG8_SA
#undef PG8_SB
#undef PG8_STAGE
#undef PG8_LDA
#undef PG8_LDB
#undef PG8_MMA
#undef PG8_WAIT_V
#undef PG8_WAIT_L
#undef PG8_BAR
#undef PG8_SCHED
}
}


constexpr int NWAVES = 8;
constexpr int NB = 8, SEQ = 2048, TOK = NB * SEQ, DM = 1024, NL = 2;
constexpr int INC = 2472;
constexpr int PP = 3584;
constexpr int FFH = 2816;
constexpr float EPS = 1e-6f;
constexpr float LOG2E = 1.4426950408889634f;
constexpr int C_CQ = 0;
constexpr int C_US5 = 256;
constexpr int C_DQ = 512;
constexpr int C_GATE = 768;
constexpr int C_DK = 1024, C_DV = 1280;
constexpr int C_MQ = 1536;
constexpr int C_MKV = 1920;
constexpr int C_CKV = 2432;
constexpr int C_DN = 2560;
constexpr int C_KR = 3328;
constexpr int C_A = 3360, C_B = 3364;

constexpr size_t WS_CTL = 0, CTL_ZERO_BYTES = 1u << 20;
constexpr size_t SZ_WIN = (size_t)PP * DM * 2, SZ_WOUT = (size_t)DM * DM * 2, SZ_W13 = (size_t)2 * FFH * DM * 2, SZ_W2 = (size_t)DM * FFH * 2, SZ_WGLU = (size_t)512 * 256 * 2;
constexpr size_t SZ_AB = 16 * 64 * 2 * 4, SZ_BB = 16 * 64 * 16 * 2 * 4;
constexpr size_t LW_WIN = 0, LW_WOUT = LW_WIN + SZ_WIN, LW_W13 = LW_WOUT + SZ_WOUT, LW_W2 = LW_W13 + SZ_W13, LW_WGLU = LW_W2 + SZ_W2, LW_AB = LW_WGLU + SZ_WGLU, LW_BB = LW_AB + SZ_AB, LW_SIZE = LW_BB + SZ_BB;
constexpr size_t WS_LW = 1u << 20;
constexpr size_t WS_BIAS = WS_LW + NL * LW_SIZE;
constexpr size_t WS_XB = WS_BIAS + 8192;
constexpr size_t WS_SSQ = WS_XB + (size_t)TOK * DM * 2;
constexpr size_t SZ_SSQ = (size_t)TOK * 16 * 4;
constexpr size_t WS_PROJ = WS_SSQ + 5 * SZ_SSQ;
constexpr size_t WS_DNB = WS_PROJ + (size_t)TOK * PP * 2;
constexpr size_t WS_GB = WS_DNB + (size_t)TOK * 768 * 2;
constexpr size_t WS_YS5 = WS_GB + (size_t)TOK * 8 * 4;
constexpr size_t WS_END = WS_YS5 + (size_t)TOK * 256 * 2;
static_assert(WS_END <= 268435456ull, "d_ws map must fit 256 MiB");
static_assert(WS_LW % 256 == 0 && LW_SIZE % 256 == 0 && WS_XB % 256 == 0 && WS_PROJ % 256 == 0, "alignment");
constexpr int CW_TMO = 0;
constexpr int CW_Q = 512;
constexpr int CW_BAR = 4096;

constexpr int WSCR = 18432;
constexpr int SCR_BYTES = NWAVES * WSCR;
constexpr int TBL_OFF = SCR_BYTES;
constexpr int MISC_OFF = TBL_OFF + 6400;
constexpr int INP_OFF = MISC_OFF + 256;
constexpr int LDS_BYTES = INP_OFF + 256;
static_assert(LDS_BYTES <= 160 * 1024, "LDS");

#define GAS __attribute__((address_space(1)))
#define LAS __attribute__((address_space(3)))
typedef unsigned short bf16;
typedef float f32x4 __attribute__((ext_vector_type(4)));
typedef short bf16x8 __attribute__((ext_vector_type(8)));
typedef short s16x4 __attribute__((ext_vector_type(4)));
typedef unsigned u32x4 __attribute__((ext_vector_type(4)));
typedef unsigned u32x2 __attribute__((ext_vector_type(2)));
typedef GAS unsigned gu32;
#define RLX_AGENT __ATOMIC_RELAXED, __HIP_MEMORY_SCOPE_AGENT
#define WAVE_FENCE() do { asm volatile("" ::: "memory"); __builtin_amdgcn_wave_barrier(); asm volatile("" ::: "memory"); } while (0)

__device__ __forceinline__ float bf_lo(unsigned u) { return __uint_as_float(u << 16); }
__device__ __forceinline__ float bf_hi(unsigned u) { return __uint_as_float(u & 0xffff0000u); }
__device__ __forceinline__ float bf2f(bf16 u) { return __uint_as_float((unsigned)u << 16); }
__device__ __forceinline__ unsigned f2bf(float f) { unsigned u = __builtin_bit_cast(unsigned, f); return (u + 0x7fffu + ((u >> 16) & 1u)) >> 16; }
__device__ __forceinline__ unsigned pk2(float lo, float hi) { return f2bf(lo) | (f2bf(hi) << 16); }
__device__ __forceinline__ float wave_sum(float v) {
#pragma unroll
    for (int o = 1; o < 64; o <<= 1) v += __shfl_xor(v, o);
    return v;
}
__device__ __forceinline__ float grp16_sum(float v) {
#pragma unroll
    for (int o = 1; o < 16; o <<= 1) v += __shfl_xor(v, o);
    return v;
}
__device__ __forceinline__ float silu_f(float x) { return x / (1.0f + __expf(-x)); }

#if MK_MODE == 2
#define XB_TMO      128
#define XB_XCNT(j)  (256  + 64 * (j))
#define XB_XSUB(j)  (1280 + 64 * (j))
#define XB_XGEN(j)  (2304 + 64 * (j))
#define XB_TOP      3328
#define XB_TOPGEN   3392
#define XCD_BAR_WORDS 3456
#define XB_SPIN_CAP (1u << 20)
__device__ __forceinline__ unsigned xb_ld(unsigned* p)              { return __hip_atomic_load(p, __ATOMIC_RELAXED, __HIP_MEMORY_SCOPE_AGENT); }
__device__ __forceinline__ unsigned xb_add(unsigned* p, unsigned v) { return __hip_atomic_fetch_add(p, v, __ATOMIC_RELAXED, __HIP_MEMORY_SCOPE_AGENT); }
__device__ __forceinline__ unsigned xb_xcc_id() { return (unsigned)__builtin_amdgcn_s_getreg((3 << 11) | 20) & 0xFu; }
#define XB_SPIN(cond, bar) do { unsigned _sp = 0; while (cond) { __builtin_amdgcn_s_sleep(1); \
    if ((++_sp & 255u) == 0u) { if (xb_ld(&(bar)[XB_TMO])) break; if (_sp > XB_SPIN_CAP) { atomicAdd(&(bar)[XB_TMO], 1u); break; } } } } while (0)
struct XcdBarrier { unsigned* bar; unsigned x; volatile LAS unsigned* st; };
__device__ __forceinline__ XcdBarrier xcd_barrier_post(unsigned* bar, volatile LAS unsigned* st) {
    XcdBarrier b; b.bar = bar; b.x = xb_xcc_id(); b.st = st;
    if (threadIdx.x == 0) (void)xb_add(&bar[XB_XCNT(b.x)], 1u);
    return b;
}
__device__ __forceinline__ void xcd_barrier_complete(unsigned* bar, unsigned x, unsigned& nloc, unsigned& nx) {
    const unsigned G = gridDim.x * gridDim.y * gridDim.z;
    unsigned sum, cnt, mine, sp = 0u;
    for (;;) {
        sum = 0u; cnt = 0u; mine = 0u;
#pragma unroll
        for (unsigned j = 0; j < 16; ++j) { const unsigned c = xb_ld(&bar[XB_XCNT(j)]); sum += c; cnt += (c > 0u) ? 1u : 0u; mine = (j == x) ? c : mine; }
        if (sum == G) break;
        __builtin_amdgcn_s_sleep(1);
        if ((++sp & 255u) == 0u) { if (xb_ld(&bar[XB_TMO])) break; if (sp > XB_SPIN_CAP) { atomicAdd(&bar[XB_TMO], 1u); break; } }
    }
    nloc = mine > 0u ? mine : 1u; nx = cnt > 0u ? cnt : 1u;
}
__device__ __forceinline__ void xcd_barrier(const XcdBarrier& b) {
    asm volatile("s_waitcnt vmcnt(0)" ::: "memory");
    __syncthreads();
    if (threadIdx.x == 0) {
        unsigned* bar = b.bar;
        __builtin_amdgcn_s_waitcnt(0);
        unsigned nloc = b.st[0], nx = b.st[1];
        if (nloc == 0u) { xcd_barrier_complete(bar, b.x, nloc, nx); b.st[0] = nloc; b.st[1] = nx; }
        const unsigned old = xb_add(&bar[XB_XSUB(b.x)], 1u);
        const unsigned gen = old / nloc;
        if (old + 1u == (gen + 1u) * nloc) {
            __builtin_amdgcn_fence(__ATOMIC_RELEASE, "agent");
            asm volatile("s_waitcnt vmcnt(0)" ::: "memory");
            const unsigned og = xb_add(&bar[XB_TOP], 1u);
            const unsigned tg = og / nx;
            if (og + 1u == (tg + 1u) * nx) xb_add(&bar[XB_TOPGEN], 1u);
            else XB_SPIN(xb_ld(&bar[XB_TOPGEN]) == tg, bar);
            __builtin_amdgcn_fence(__ATOMIC_ACQUIRE, "agent");
            xb_add(&bar[XB_XGEN(b.x)], 1u);
            asm volatile("s_waitcnt vmcnt(0)" ::: "memory");
        } else {
            XB_SPIN(xb_ld(&bar[XB_XGEN(b.x)]) == gen, bar);
            __builtin_amdgcn_fence(__ATOMIC_ACQUIRE, "agent");
            asm volatile("s_waitcnt vmcnt(0)" ::: "memory");
        }
    }
    __syncthreads();
}
#endif

struct Frame {
    LAS unsigned char* lds;
    unsigned char* ws;
    float* out;
    int tid, lane, wave, vcu, G;
};
__device__ __forceinline__ const float* inp(const Frame& F, int i) {
    const LAS unsigned* t = (const LAS unsigned*)(F.lds + INP_OFF) + 2 * i;
    const unsigned lo = __builtin_amdgcn_readfirstlane(t[0]), hi = __builtin_amdgcn_readfirstlane(t[1]);
    return (const float*)(((unsigned long long)hi << 32) | lo);
}
__device__ __forceinline__ bf16* XB_(const Frame& F) { return (bf16*)(F.ws + WS_XB); }
__device__ __forceinline__ bf16* PROJ_(const Frame& F) { return (bf16*)(F.ws + WS_PROJ); }
__device__ __forceinline__ bf16* DNB_(const Frame& F) { return (bf16*)(F.ws + WS_DNB); }
__device__ __forceinline__ bf16* YS5_(const Frame& F) { return (bf16*)(F.ws + WS_YS5); }
__device__ __forceinline__ float* SSQ_(const Frame& F) { return (float*)(F.ws + WS_SSQ); }
__device__ __forceinline__ float* GB_(const Frame& F) { return (float*)(F.ws + WS_GB); }
__device__ __forceinline__ float* BIAS_(const Frame& F) { return (float*)(F.ws + WS_BIAS); }
__device__ __forceinline__ gu32* CTL_(const Frame& F) { return (gu32*)(F.ws + WS_CTL); }
__device__ __forceinline__ unsigned char* lw(const Frame& F, int l) { return F.ws + WS_LW + (size_t)l * LW_SIZE; }

__device__ __forceinline__ void tr_item(const float* W, int ld, int srccol0, int nvalid, const float* scale, int k0, bf16* dst, int n0, int Kd, LAS float* scr, int lane) {
    const int nn = lane & 31; const bool ok = nn < nvalid;
#pragma unroll 8
    for (int i = 0; i < 32; ++i) { const int kk = 2 * i + (lane >> 5); float v = 0.f;
        if (ok) { v = W[(size_t)(k0 + kk) * ld + srccol0 + nn]; if (scale) v *= scale[k0 + kk]; }
        scr[kk * 33 + nn] = v; }
    WAVE_FENCE();
    const int c = lane & 7;
#pragma unroll
    for (int j = 0; j < 4; ++j) { const int n = (lane >> 3) + 8 * j; const LAS float* s = scr + (8 * c) * 33 + n;
        u32x4 o; o.x = pk2(s[0 * 33], s[1 * 33]); o.y = pk2(s[2 * 33], s[3 * 33]); o.z = pk2(s[4 * 33], s[5 * 33]); o.w = pk2(s[6 * 33], s[7 * 33]);
        *(u32x4*)(dst + (size_t)(n0 + n) * Kd + k0 + 8 * c) = o; }
    WAVE_FENCE();
}
__device__ __forceinline__ bool win_map(int n0, int& src, int& nvalid) {
    nvalid = 32;
    if (n0 < 256) { src = n0; return true; }
    if (n0 < 512) { src = 416 + (n0 - 256); return true; }
    if (n0 < 768) { src = 672 + (n0 - 512); return true; }
    if (n0 < 1024) { src = 2216 + (n0 - 768); return true; }
    if (n0 < 1280) { src = 928 + (n0 - 1024); return true; }
    if (n0 < 1536) { src = 1184 + (n0 - 1280); return true; }
    if (n0 < 2432) return false;
    if (n0 < 2560) { src = 256 + (n0 - 2432); return true; }
    if (n0 < 3328) { src = 1440 + (n0 - 2560); return true; }
    if (n0 < 3360) { src = 384 + (n0 - 3328); return true; }
    if (n0 < 3392) { src = 2208; nvalid = 8; return true; }
    src = 0; nvalid = 0; return true;
}
__device__ __forceinline__ void p0_prologue(Frame& F) {
    LAS float* scr = (LAS float*)(F.lds + F.wave * WSCR);
    const int gw = F.vcu * NWAVES + F.wave, NGW = F.G * NWAVES, lane = F.lane;
    constexpr int I_WIN = (PP / 32) * (DM / 64), I_WOUT = (DM / 32) * (DM / 64), I_W13 = (2 * FFH / 32) * (DM / 64), I_W2 = (DM / 32) * (FFH / 64), I_GLU = (512 / 32) * (256 / 64);
    constexpr int I_L = I_WIN + I_WOUT + I_W13 + I_W2 + I_GLU;
    for (int it = gw; it < NL * I_L; it += NGW) {
        const int l = it / I_L; int r = it % I_L; unsigned char* L = lw(F, l);
        if (r < I_WIN) { const int nb = r / (DM / 64), kb = r % (DM / 64); int src, nv; if (!win_map(32 * nb, src, nv)) continue;
            tr_item(inp(F, 2) + (size_t)l * DM * INC, INC, src, nv, inp(F, 1) + l * DM, 64 * kb, (bf16*)(L + LW_WIN), 32 * nb, DM, scr, lane); continue; }
        r -= I_WIN;
        if (r < I_WOUT) { const int nb = r / (DM / 64), kb = r % (DM / 64);
            tr_item(inp(F, 3) + (size_t)l * DM * DM, DM, 32 * nb, 32, nullptr, 64 * kb, (bf16*)(L + LW_WOUT), 32 * nb, DM, scr, lane); continue; }
        r -= I_WOUT;
        if (r < I_W13) { const int nb = r / (DM / 64), kb = r % (DM / 64); const int n0 = 32 * nb, t = n0 >> 8, i = n0 & 255;
            const float* W = (i < 128 ? inp(F, 27) : inp(F, 28)) + (size_t)l * DM * FFH;
            tr_item(W, FFH, 128 * t + (i & 127), 32, inp(F, 26) + l * DM, 64 * kb, (bf16*)(L + LW_W13), n0, DM, scr, lane); continue; }
        r -= I_W13;
        if (r < I_W2) { const int nb = r / (FFH / 64), kb = r % (FFH / 64);
            tr_item(inp(F, 29) + (size_t)l * FFH * DM, DM, 32 * nb, 32, nullptr, 64 * kb, (bf16*)(L + LW_W2), 32 * nb, FFH, scr, lane); continue; }
        r -= I_W2;
        { const int nb = r / 4, kb = r % 4; const int n0 = 32 * nb, t = n0 >> 8, i = n0 & 255;
            tr_item(inp(F, 18) + (size_t)l * 256 * 512, 512, (i < 128 ? 0 : 256) + 128 * t + (i & 127), 32, nullptr, 64 * kb, (bf16*)(L + LW_WGLU), n0, 256, scr, lane); }
    }
    for (int it = gw; it < NL * DM * 14; it += NGW) {
        const int l = it / (DM * 14), r = it % (DM * 14), k = r / 14, ch = r % 14;
        const float* wrow = inp(F, 2) + (size_t)l * DM * INC + (size_t)k * INC; const float gk = inp(F, 1)[l * DM + k];
        bf16* WT = (bf16*)(lw(F, l) + LW_WIN);
        if (ch < 6) { const int n = 64 * ch + lane; const float* wu = inp(F, 6) + (size_t)l * 256 * 384 + n; const float* gn = inp(F, 4) + l * 256;
            float wv[4];
#pragma unroll
            for (int jj = 0; jj < 4; ++jj) wv[jj] = wrow[64 * jj + lane] * gn[64 * jj + lane];
            float acc = 0.f;
#pragma unroll
            for (int jj = 0; jj < 4; ++jj)
#pragma unroll 16
                for (int j = 0; j < 64; ++j) acc += __shfl(wv[jj], j) * wu[(size_t)(64 * jj + j) * 384];
            WT[(size_t)(C_MQ + n) * DM + k] = (bf16)f2bf(acc * gk);
        } else { const int n = 64 * (ch - 6) + lane; const float* wu = inp(F, 7) + (size_t)l * 128 * 512 + n; const float* gn = inp(F, 5) + l * 128;
            float wv[2];
#pragma unroll
            for (int jj = 0; jj < 2; ++jj) wv[jj] = wrow[256 + 64 * jj + lane] * gn[64 * jj + lane];
            float acc = 0.f;
#pragma unroll
            for (int jj = 0; jj < 2; ++jj)
#pragma unroll 16
                for (int j = 0; j < 64; ++j) acc += __shfl(wv[jj], j) * wu[(size_t)(64 * jj + j) * 512];
            WT[(size_t)(C_MKV + n) * DM + k] = (bf16)f2bf(acc * gk);
        }
    }
    for (int m = gw; m < TOK; m += NGW) {
        const f32x4* xr = (const f32x4*)(inp(F, 0) + (size_t)m * DM) + lane; float s = 0.f; u32x2* o8 = (u32x2*)(XB_(F) + (size_t)m * DM) + lane;
#pragma unroll
        for (int j = 0; j < 4; ++j) { const f32x4 v = xr[64 * j]; s += (v[0] * v[0] + v[1] * v[1]) + (v[2] * v[2] + v[3] * v[3]); u32x2 w; w.x = pk2(v[0], v[1]); w.y = pk2(v[2], v[3]); o8[64 * j] = w; }
        s = wave_sum(s);
        if (lane < 16) SSQ_(F)[(size_t)m * 16 + lane] = (lane == 0) ? s : 0.f;
    }
    for (int it = gw; it < NL * 16; it += NGW) {
        const int l = it / 16, g = it % 16, p = lane; const int gi = l * 16 + g;
        const double lr = inp(F, 10)[gi * 64 + p], li = inp(F, 11)[gi * 64 + p], dt = exp((double)inp(F, 12)[gi]);
        const double mag = exp(lr * dt), ar = mag * cos(li * dt), ai = mag * sin(li * dt), den = lr * lr + li * li, nr = ar - 1.0, ni = ai;
        const double zr = (nr * lr + ni * li) / den, zi = (ni * lr - nr * li) / den;
        float* AB = (float*)(lw(F, l) + LW_AB) + (g * 64 + p) * 2; AB[0] = (float)ar; AB[1] = (float)ai;
        float* BB = (float*)(lw(F, l) + LW_BB) + (size_t)(g * 64 + p) * 32;
        for (int c = 0; c < 16; ++c) { const double br = inp(F, 13)[((size_t)gi * 64 + p) * 16 + c], bi = inp(F, 14)[((size_t)gi * 64 + p) * 16 + c];
            BB[2 * c] = (float)(zr * br - zi * bi); BB[2 * c + 1] = (float)(zr * bi + zi * br); }
    }
    if (gw == 0) {
        for (int e = lane; e < 3 * 129; e += 64) { const int br = e / 129, delta = e % 129, dil = (br == 0) ? 1 : (br == 1 ? 4 : 16); const int dist = delta * dil;
            int bk; if (dist < 16) bk = dist; else { const float df = (float)dist; int lg = 16 + (int)(logf(df / 16.0f) / logf(128.0f) * 16.0f); bk = lg < 31 ? lg : 31; }
            for (int h = 0; h < 4; ++h) BIAS_(F)[e * 4 + h] = inp(F, 21)[bk * 4 + h] * LOG2E; }
    }
}

__device__ __forceinline__ void prep_token(Frame& F, int l, int t) {
    const int lane = F.lane, hh = lane >> 4, ii = lane & 15, s = t & (SEQ - 1);
    bf16* row = PROJ_(F) + (size_t)t * PP;
    float rs_q, rs_kv;
    { const u32x2 cq = *(const u32x2*)(row + C_CQ + 4 * lane); const float a = bf_lo(cq.x), b = bf_hi(cq.x), c = bf_lo(cq.y), d = bf_hi(cq.y);
      rs_q = 1.0f / sqrtf(wave_sum((a * a + b * b) + (c * c + d * d)) * (1.0f / 256.0f) + EPS);
      const unsigned ck = *(const unsigned*)(row + C_CKV + 2 * lane); const float e = bf_lo(ck), f = bf_hi(ck);
      rs_kv = 1.0f / sqrtf(wave_sum(e * e + f * f) * (1.0f / 128.0f) + EPS); }
    const float freq = exp2f(-(float)ii * (13.287712379549449f / 16.0f));
    float cs, sn; sincosf((float)s * freq, &sn, &cs);
    {
      bf16* qp = row + C_MQ + hh * 96; const u32x2 qn = *(const u32x2*)(qp + 4 * ii);
      float q0 = bf_lo(qn.x) * rs_q, q1 = bf_hi(qn.x) * rs_q, q2 = bf_lo(qn.y) * rs_q, q3 = bf_hi(qn.y) * rs_q, x1 = bf2f(qp[64 + ii]) * rs_q, x2 = bf2f(qp[80 + ii]) * rs_q;
      const float ss = grp16_sum((q0 * q0 + q1 * q1) + (q2 * q2 + q3 * q3) + (x1 * x1 + x2 * x2));
      const float* gq = inp(F, 8) + l * 96; const float rn = (1.0f / sqrtf(ss * (1.0f / 96.0f) + EPS)) * (0.10206207261596577f * LOG2E);
      q0 *= rn * gq[4 * ii]; q1 *= rn * gq[4 * ii + 1]; q2 *= rn * gq[4 * ii + 2]; q3 *= rn * gq[4 * ii + 3]; x1 *= rn * gq[64 + ii]; x2 *= rn * gq[80 + ii];
      u32x2 w; w.x = pk2(q0, q1); w.y = pk2(q2, q3); *(u32x2*)(qp + 4 * ii) = w;
      qp[64 + ii] = (bf16)f2bf(x1 * cs - x2 * sn); qp[80 + ii] = (bf16)f2bf(x1 * sn + x2 * cs); }
    {
      bf16* kp = row + C_MKV + hh * 128; const u32x2 kn = *(const u32x2*)(kp + 4 * ii); const u32x2 vv = *(const u32x2*)(kp + 64 + 4 * ii);
      float k0 = bf_lo(kn.x) * rs_kv, k1 = bf_hi(kn.x) * rs_kv, k2 = bf_lo(kn.y) * rs_kv, k3 = bf_hi(kn.y) * rs_kv, x1 = bf2f(row[C_KR + ii]), x2 = bf2f(row[C_KR + 16 + ii]);
      const float ss = grp16_sum((k0 * k0 + k1 * k1) + (k2 * k2 + k3 * k3) + (x1 * x1 + x2 * x2));
      const float* gk = inp(F, 9) + l * 96; const float rn = 1.0f / sqrtf(ss * (1.0f / 96.0f) + EPS);
      k0 *= rn * gk[4 * ii]; k1 *= rn * gk[4 * ii + 1]; k2 *= rn * gk[4 * ii + 2]; k3 *= rn * gk[4 * ii + 3]; x1 *= rn * gk[64 + ii]; x2 *= rn * gk[80 + ii];
      u32x2 w; w.x = pk2(k0, k1); w.y = pk2(k2, k3); *(u32x2*)(kp + 4 * ii) = w;
      u32x2 wv; wv.x = pk2(bf_lo(vv.x) * rs_kv, bf_hi(vv.x) * rs_kv); wv.y = pk2(bf_lo(vv.y) * rs_kv, bf_hi(vv.y) * rs_kv); *(u32x2*)(kp + 64 + 4 * ii) = wv;
      bf16* rp = row + C_CKV + hh * 32; rp[ii] = (bf16)f2bf(x1 * cs - x2 * sn); rp[16 + ii] = (bf16)f2bf(x1 * sn + x2 * cs); }
    { bf16* qp = row + C_DQ + hh * 64 + 4 * ii; const u32x2 qn = *(const u32x2*)qp; float a = bf_lo(qn.x), b = bf_hi(qn.x), c = bf_lo(qn.y), d = bf_hi(qn.y);
      const float* g = inp(F, 19) + l * 64 + 4 * ii; const float rn = (1.0f / sqrtf(grp16_sum((a * a + b * b) + (c * c + d * d)) * (1.0f / 64.0f) + EPS)) * (0.125f * LOG2E);
      u32x2 w; w.x = pk2(a * rn * g[0], b * rn * g[1]); w.y = pk2(c * rn * g[2], d * rn * g[3]); *(u32x2*)qp = w; }
    { bf16* kp = row + C_DK + hh * 64 + 4 * ii; const u32x2 kn = *(const u32x2*)kp; float a = bf_lo(kn.x), b = bf_hi(kn.x), c = bf_lo(kn.y), d = bf_hi(kn.y);
      const float* g = inp(F, 20) + l * 64 + 4 * ii; const float rn = 1.0f / sqrtf(grp16_sum((a * a + b * b) + (c * c + d * d)) * (1.0f / 64.0f) + EPS);
      u32x2 w; w.x = pk2(a * rn * g[0], b * rn * g[1]); w.y = pk2(c * rn * g[2], d * rn * g[3]); *(u32x2*)kp = w; }
    { const float* cw = inp(F, 22) + (size_t)l * 4 * 768; bf16* dst = DNB_(F) + (size_t)t * 768;
#pragma unroll
      for (int w3 = 0; w3 < 3; ++w3) { const int c0 = w3 * 256 + hh * 64 + 4 * ii; float a[4] = {0.f, 0.f, 0.f, 0.f};
#pragma unroll
          for (int j = 0; j < 4; ++j) { if (s - 3 + j >= 0) { const u32x2 xv = *(const u32x2*)(row + (ptrdiff_t)(j - 3) * PP + C_DN + c0); const f32x4 wj = *(const f32x4*)(cw + j * 768 + c0);
              a[0] += wj[0] * bf_lo(xv.x); a[1] += wj[1] * bf_hi(xv.x); a[2] += wj[2] * bf_lo(xv.y); a[3] += wj[3] * bf_hi(xv.y); } }
#pragma unroll
          for (int e = 0; e < 4; ++e) a[e] = silu_f(a[e]);
          float sc = 1.0f;
          if (w3 < 2) { sc = 1.0f / sqrtf(grp16_sum((a[0] * a[0] + a[1] * a[1]) + (a[2] * a[2] + a[3] * a[3])) + EPS); if (w3 == 0) sc *= 0.125f; }
          u32x2 w; w.x = pk2(a[0] * sc, a[1] * sc); w.y = pk2(a[2] * sc, a[3] * sc); *(u32x2*)(dst + c0) = w; }
      if (lane < 4) { const float av = bf2f(row[C_A + lane]), bv = bf2f(row[C_B + lane]); const float xx = av + inp(F, 24)[l * 4 + lane];
          const float sp = xx > 20.f ? xx : log1pf(expf(xx)); GB_(F)[(size_t)t * 8 + lane] = -expf(inp(F, 23)[l * 4 + lane]) * sp; GB_(F)[(size_t)t * 8 + 4 + lane] = 1.0f / (1.0f + expf(-bv)); } }
}

constexpr int VP = 144;
__device__ __forceinline__ s16x4 tr_read(const LAS unsigned char* p) {
    typedef short v4i16_t __attribute__((ext_vector_type(4)));
    return __builtin_bit_cast(s16x4, __builtin_amdgcn_ds_read_tr16_b64_v4i16((LAS v4i16_t*)p));
}
__device__ __forceinline__ unsigned cvtpk(float lo, float hi) { typedef float f2 __attribute__((ext_vector_type(2))); typedef __bf16 b2 __attribute__((ext_vector_type(2))); f2 v = {lo, hi}; return __builtin_bit_cast(unsigned, __builtin_convertvector(v, b2)); }
template <int NKS, class MB>
__device__ __forceinline__ void attn_core(const bf16x8 (&qf)[NKS], const bf16x8 (&kf)[2][NKS], const u32x4 (&vr)[4], const MB& mb, LAS unsigned char* vl, int lane, float& m, float& l, f32x4 (&o)[4]) {
    f32x4 s0 = {0.f, 0.f, 0.f, 0.f}, s1 = {0.f, 0.f, 0.f, 0.f};
#pragma unroll
    for (int ks = 0; ks < NKS; ++ks) { s0 = __builtin_amdgcn_mfma_f32_16x16x32_bf16(kf[0][ks], qf[ks], s0, 0, 0, 0); s1 = __builtin_amdgcn_mfma_f32_16x16x32_bf16(kf[1][ks], qf[ks], s1, 0, 0, 0); }
    mb(s0, s1);
    float mx = fmaxf(fmaxf(fmaxf(s0[0], s0[1]), fmaxf(s0[2], s0[3])), fmaxf(fmaxf(s1[0], s1[1]), fmaxf(s1[2], s1[3])));
    mx = fmaxf(mx, __shfl_xor(mx, 16)); mx = fmaxf(mx, __shfl_xor(mx, 32));
    const float mn = fmaxf(m, mx), alpha = __builtin_amdgcn_exp2f(m - mn); m = mn;
    float p0[4], p1[4], ps = 0.f;
#pragma unroll
    for (int i = 0; i < 4; ++i) { p0[i] = __builtin_amdgcn_exp2f(s0[i] - mn); p1[i] = __builtin_amdgcn_exp2f(s1[i] - mn); ps += p0[i] + p1[i]; }
    l = l * alpha + ps;
#pragma unroll
    for (int dt = 0; dt < 4; ++dt) o[dt] = o[dt] * alpha;
    WAVE_FENCE();
#pragma unroll
    for (int it = 0; it < 4; ++it) *(LAS u32x4*)(vl + ((lane >> 3) + 8 * it) * VP + (lane & 7) * 16) = vr[it];
    WAVE_FENCE();
    u32x4 pw; pw.x = cvtpk(p0[0], p0[1]); pw.y = cvtpk(p0[2], p0[3]); pw.z = cvtpk(p1[0], p1[1]); pw.w = cvtpk(p1[2], p1[3]);
    const bf16x8 pB = __builtin_bit_cast(bf16x8, pw);
    const int g = lane >> 4, i16 = lane & 15; const LAS unsigned char* vb = vl + (4 * g + (i16 >> 2)) * VP + (i16 & 3) * 8;
#pragma unroll
    for (int dt = 0; dt < 4; ++dt) { const s16x4 lo = tr_read(vb + dt * 32), hi = tr_read(vb + 16 * VP + dt * 32);
        const bf16x8 a = {lo[0], lo[1], lo[2], lo[3], hi[0], hi[1], hi[2], hi[3]};
        o[dt] = __builtin_amdgcn_mfma_f32_16x16x32_bf16(a, pB, o[dt], 0, 0, 0); }
    WAVE_FENCE();
}
struct MlaMask { int key0, qpos, q4;
    __device__ __forceinline__ void operator()(f32x4& s0, f32x4& s1) const {
#pragma unroll
        for (int i = 0; i < 4; ++i) { if (key0 + q4 + i > qpos) s0[i] = -INFINITY; if (key0 + 16 + q4 + i > qpos) s1[i] = -INFINITY; } } };
struct DilMask { int pq, kbase, q4, h; const LAS float* tbl;
    __device__ __forceinline__ void operator()(f32x4& s0, f32x4& s1) const {
#pragma unroll
        for (int i = 0; i < 4; ++i) {
            { const int pk = kbase + q4 + i, d = pq - pk; const int dc = d < 0 ? 0 : (d > 128 ? 128 : d); const float b = tbl[dc * 4 + h]; s0[i] = (d >= 0 && d <= 128 && pk >= 0) ? s0[i] + b : -INFINITY; }
            { const int pk = kbase + 16 + q4 + i, d = pq - pk; const int dc = d < 0 ? 0 : (d > 128 ? 128 : d); const float b = tbl[dc * 4 + h]; s1[i] = (d >= 0 && d <= 128 && pk >= 0) ? s1[i] + b : -INFINITY; } } } };

__device__ __forceinline__ void mla_item(Frame& F, int b, int h, int qt, LAS unsigned char* scr) {
    const int lane = F.lane, r = lane & 15, q = lane >> 4; const size_t rowbase = (size_t)b * SEQ; const int q0 = qt * 16;
    const bf16* P = PROJ_(F);
    bf16x8 qf[3];
    { const bf16* qp = P + (rowbase + q0 + r) * PP + C_MQ + h * 96 + 8 * q;
#pragma unroll
      for (int ks = 0; ks < 3; ++ks) qf[ks] = *(const bf16x8*)(qp + 32 * ks); }
    float m = -1e30f, l = 0.f; f32x4 o[4];
#pragma unroll
    for (int dt = 0; dt < 4; ++dt) o[dt] = (f32x4){0.f, 0.f, 0.f, 0.f};
    const int nst = (q0 + 15) / 32 + 1;
    for (int st = 0; st < nst; ++st) { const int key0 = 32 * st;
        bf16x8 kf[2][3]; u32x4 vr[4];
#pragma unroll
        for (int t = 0; t < 2; ++t) { const bf16* kr = P + (rowbase + key0 + 16 * t + r) * PP;
            kf[t][0] = *(const bf16x8*)(kr + C_MKV + h * 128 + 8 * q); kf[t][1] = *(const bf16x8*)(kr + C_MKV + h * 128 + 32 + 8 * q); kf[t][2] = *(const bf16x8*)(kr + C_CKV + h * 32 + 8 * q); }
#pragma unroll
        for (int it = 0; it < 4; ++it) vr[it] = *(const u32x4*)(P + (rowbase + key0 + (lane >> 3) + 8 * it) * PP + C_MKV + h * 128 + 64 + (lane & 7) * 8);
        const MlaMask mb{key0, q0 + r, 4 * q};
        attn_core<3, MlaMask>(qf, kf, vr, mb, scr, lane, m, l, o);
    }
    l += __shfl_xor(l, 16); l += __shfl_xor(l, 32); const float il = 1.0f / l;
    bf16* op = PROJ_(F) + (rowbase + q0 + r) * PP + C_CQ + h * 64 + 4 * q;
#pragma unroll
    for (int dt = 0; dt < 4; ++dt) { u32x2 w; w.x = pk2(o[dt][0] * il, o[dt][1] * il); w.y = pk2(o[dt][2] * il, o[dt][3] * il); *(u32x2*)(op + 16 * dt) = w; }
}
__device__ __forceinline__ void dil_item(Frame& F, int b, int h, int blk, int r16, LAS unsigned char* scr, const LAS float* tbl) {
    const int lane = F.lane, r = lane & 15, q = lane >> 4; const size_t rowbase = (size_t)b * SEQ; const int t0 = 256 * blk + r16;
    const bf16* P = PROJ_(F);
    bf16x8 qf[2];
    { const bf16* qp = P + (rowbase + t0 + 16 * r) * PP + C_DQ + h * 64 + 8 * q; qf[0] = *(const bf16x8*)qp; qf[1] = *(const bf16x8*)(qp + 32); }
    float m = -1e30f, l = 0.f; f32x4 o[4];
#pragma unroll
    for (int dt = 0; dt < 4; ++dt) o[dt] = (f32x4){0.f, 0.f, 0.f, 0.f};
    for (int br = 0; br < 3; ++br) {
        const int dil = (br == 0) ? 1 : (br == 1 ? 4 : 16), L = SEQ / dil, rd = t0 & (dil - 1), qstep = 16 / dil;
        const int pq0 = (t0 - rd) / dil;
        const int plo = pq0 - 128 < 0 ? 0 : pq0 - 128, phi = pq0 + qstep * 15;
        const int nst = (phi - plo) / 32 + 1;
        for (int st = 0; st < nst; ++st) { const int kb = plo + 32 * st;
            bf16x8 kf[2][2]; u32x4 vr[4];
#pragma unroll
            for (int t = 0; t < 2; ++t) { int pk = kb + 16 * t + r; pk = pk > L - 1 ? L - 1 : pk; const bf16* kr = P + (rowbase + rd + (size_t)dil * pk) * PP + C_DK + h * 64 + 8 * q;
                kf[t][0] = *(const bf16x8*)kr; kf[t][1] = *(const bf16x8*)(kr + 32); }
#pragma unroll
            for (int it = 0; it < 4; ++it) { int pk = kb + (lane >> 3) + 8 * it; pk = pk > L - 1 ? L - 1 : pk; vr[it] = *(const u32x4*)(P + (rowbase + rd + (size_t)dil * pk) * PP + C_DV + h * 64 + (lane & 7) * 8); }
            const DilMask mb{pq0 + qstep * r, kb, 4 * q, h, tbl + br * 129 * 4};
            attn_core<2, DilMask>(qf, kf, vr, mb, scr, lane, m, l, o);
        }
    }
    l += __shfl_xor(l, 16); l += __shfl_xor(l, 32); const float il = 1.0f / l;
    bf16* op = PROJ_(F) + (rowbase + t0 + 16 * r) * PP + C_DQ + h * 64 + 4 * q;
#pragma unroll
    for (int dt = 0; dt < 4; ++dt) { u32x2 w; w.x = pk2(o[dt][0] * il, o[dt][1] * il); w.y = pk2(o[dt][2] * il, o[dt][3] * il); *(u32x2*)(op + 16 * dt) = w; }
}
__device__ __forceinline__ void s5_item(Frame& F, int l, int b, int g, LAS unsigned char* scr) {
    const int lane = F.lane, tk = lane >> 2, c4 = lane & 3, gi = l * 16 + g;
    LAS float* Cs = (LAS float*)scr;
    LAS float* Hs = (LAS float*)(scr + 8192);
    LAS float* Us = (LAS float*)(scr + 16384);
    for (int c = 0; c < 16; ++c) { Cs[(lane * 16 + c) * 2] = inp(F, 15)[((size_t)gi * 16 + c) * 64 + lane]; Cs[(lane * 16 + c) * 2 + 1] = inp(F, 16)[((size_t)gi * 16 + c) * 64 + lane]; }
    const float* AB = (const float*)(lw(F, l) + LW_AB) + (g * 64 + lane) * 2; const float ar = AB[0], ai = AB[1];
    float bbr[16], bbi[16];
    { const f32x4* BB = (const f32x4*)((const float*)(lw(F, l) + LW_BB) + (size_t)(g * 64 + lane) * 32);
#pragma unroll
      for (int c2 = 0; c2 < 8; ++c2) { const f32x4 v = BB[c2]; bbr[2 * c2] = v[0]; bbi[2 * c2] = v[1]; bbr[2 * c2 + 1] = v[2]; bbi[2 * c2 + 1] = v[3]; } }
    float dsk[4];
#pragma unroll
    for (int e = 0; e < 4; ++e) dsk[e] = inp(F, 17)[l * 256 + g * 16 + 4 * c4 + e];
    float hr = 0.f, hi = 0.f;
    WAVE_FENCE();
    for (int bt = 0; bt < SEQ / 16; ++bt) { const size_t t0 = (size_t)b * SEQ + bt * 16;
        const u32x2 uu = *(const u32x2*)(PROJ_(F) + (t0 + tk) * PP + C_US5 + g * 16 + 4 * c4);
        const f32x4 uf = {bf_lo(uu.x), bf_hi(uu.x), bf_lo(uu.y), bf_hi(uu.y)};
        *(LAS f32x4*)(Us + tk * 16 + 4 * c4) = uf;
        WAVE_FENCE();
#pragma unroll 4
        for (int tok = 0; tok < 16; ++tok) {
            float xr = 0.f, xi = 0.f;
#pragma unroll
            for (int c2 = 0; c2 < 4; ++c2) { const f32x4 u = *(const LAS f32x4*)(Us + tok * 16 + 4 * c2);
#pragma unroll
                for (int e = 0; e < 4; ++e) { xr += bbr[4 * c2 + e] * u[e]; xi += bbi[4 * c2 + e] * u[e]; } }
            const float nhr = ar * hr - ai * hi + xr, nhi = ar * hi + ai * hr + xi; hr = nhr; hi = nhi;
            typedef float f2 __attribute__((ext_vector_type(2)));
            *(LAS f2*)(Hs + (tok * 64 + lane) * 2) = (f2){hr, hi};
        }
        WAVE_FENCE();
        float y[4] = {0.f, 0.f, 0.f, 0.f};
#pragma unroll 8
        for (int p = 0; p < 64; ++p) { typedef float f2 __attribute__((ext_vector_type(2)));
            const f2 hv = *(const LAS f2*)(Hs + (tk * 64 + p) * 2); const f32x4 ca = *(const LAS f32x4*)(Cs + (p * 16 + 4 * c4) * 2), cb = *(const LAS f32x4*)(Cs + (p * 16 + 4 * c4) * 2 + 4);
            y[0] += ca[0] * hv.x - ca[1] * hv.y; y[1] += ca[2] * hv.x - ca[3] * hv.y; y[2] += cb[0] * hv.x - cb[1] * hv.y; y[3] += cb[2] * hv.x - cb[3] * hv.y; }
        u32x2 w; w.x = pk2(y[0] + dsk[0] * uf[0], y[1] + dsk[1] * uf[1]); w.y = pk2(y[2] + dsk[2] * uf[2], y[3] + dsk[3] * uf[3]);
        *(u32x2*)(YS5_(F) + (t0 + tk) * 256 + g * 16 + 4 * c4) = w;
        WAVE_FENCE();
    }
}
__device__ __forceinline__ void dn_item(Frame& F, int l, int b, int h, LAS unsigned char* scr) {
    const int lane = F.lane, tk = lane >> 3, ch = lane & 7;
    LAS float* Qs = (LAS float*)scr; LAS float* Ks = Qs + 512; LAS float* Vs = Ks + 512; LAS float* Ts = Vs + 512; LAS float* Gs = Ts + 512;
    float S[64];
#pragma unroll
    for (int d = 0; d < 64; ++d) S[d] = 0.f;
    const float onorm = inp(F, 25)[l * 64 + lane];
    for (int bt = 0; bt < SEQ / 8; ++bt) { const size_t t0 = (size_t)b * SEQ + bt * 8;
        { const bf16* src = DNB_(F) + (t0 + tk) * 768 + h * 64 + 8 * ch;
          const u32x4 q8 = *(const u32x4*)src, k8 = *(const u32x4*)(src + 256), v8 = *(const u32x4*)(src + 512);
          *(LAS f32x4*)(Qs + tk * 64 + 8 * ch) = (f32x4){bf_lo(q8.x), bf_hi(q8.x), bf_lo(q8.y), bf_hi(q8.y)}; *(LAS f32x4*)(Qs + tk * 64 + 8 * ch + 4) = (f32x4){bf_lo(q8.z), bf_hi(q8.z), bf_lo(q8.w), bf_hi(q8.w)};
          *(LAS f32x4*)(Ks + tk * 64 + 8 * ch) = (f32x4){bf_lo(k8.x), bf_hi(k8.x), bf_lo(k8.y), bf_hi(k8.y)}; *(LAS f32x4*)(Ks + tk * 64 + 8 * ch + 4) = (f32x4){bf_lo(k8.z), bf_hi(k8.z), bf_lo(k8.w), bf_hi(k8.w)};
          *(LAS f32x4*)(Vs + tk * 64 + 8 * ch) = (f32x4){bf_lo(v8.x), bf_hi(v8.x), bf_lo(v8.y), bf_hi(v8.y)}; *(LAS f32x4*)(Vs + tk * 64 + 8 * ch + 4) = (f32x4){bf_lo(v8.z), bf_hi(v8.z), bf_lo(v8.w), bf_hi(v8.w)};
          if (lane < 8) { Gs[lane * 2] = GB_(F)[(t0 + lane) * 8 + h]; Gs[lane * 2 + 1] = GB_(F)[(t0 + lane) * 8 + 4 + h]; } }
        { const u32x4 g8 = *(const u32x4*)(PROJ_(F) + (t0 + tk) * PP + C_GATE + h * 64 + 8 * ch);
          *(LAS f32x4*)(Ts + tk * 64 + 8 * ch) = (f32x4){bf_lo(g8.x), bf_hi(g8.x), bf_lo(g8.y), bf_hi(g8.y)}; *(LAS f32x4*)(Ts + tk * 64 + 8 * ch + 4) = (f32x4){bf_lo(g8.z), bf_hi(g8.z), bf_lo(g8.w), bf_hi(g8.w)}; }
        WAVE_FENCE();
#pragma unroll 1
        for (int tok = 0; tok < 8; ++tok) {
            const float eg = __expf(Gs[tok * 2]), bta = Gs[tok * 2 + 1];
            float a0 = 0.f, a1 = 0.f, a2 = 0.f, a3 = 0.f;
#pragma unroll
            for (int d4 = 0; d4 < 16; ++d4) { const f32x4 kk = *(const LAS f32x4*)(Ks + tok * 64 + 4 * d4); a0 += kk[0] * S[4 * d4]; a1 += kk[1] * S[4 * d4 + 1]; a2 += kk[2] * S[4 * d4 + 2]; a3 += kk[3] * S[4 * d4 + 3]; }
            const float kS = (a0 + a1) + (a2 + a3);
            const float wv = bta * (Vs[tok * 64 + lane] - eg * kS);
            float o0 = 0.f, o1 = 0.f, o2 = 0.f, o3 = 0.f;
#pragma unroll
            for (int d4 = 0; d4 < 16; ++d4) { const f32x4 kk = *(const LAS f32x4*)(Ks + tok * 64 + 4 * d4), qq = *(const LAS f32x4*)(Qs + tok * 64 + 4 * d4);
                S[4 * d4] = eg * S[4 * d4] + kk[0] * wv; S[4 * d4 + 1] = eg * S[4 * d4 + 1] + kk[1] * wv; S[4 * d4 + 2] = eg * S[4 * d4 + 2] + kk[2] * wv; S[4 * d4 + 3] = eg * S[4 * d4 + 3] + kk[3] * wv;
                o0 += qq[0] * S[4 * d4]; o1 += qq[1] * S[4 * d4 + 1]; o2 += qq[2] * S[4 * d4 + 2]; o3 += qq[3] * S[4 * d4 + 3]; }
            const float ov = (o0 + o1) + (o2 + o3);
            const float ms = wave_sum(ov * ov) * (1.0f / 64.0f);
            const float yv = ov * (1.0f / sqrtf(ms + EPS)) * onorm * silu_f(Ts[tok * 64 + lane]);
            PROJ_(F)[(t0 + tok) * PP + C_GATE + h * 64 + lane] = (bf16)f2bf(yv);
        }
        WAVE_FENCE();
    }
}
constexpr int N_DN = 32, N_S5 = 128, N_ATT = 4096, N_ITEMS = N_DN + N_S5 + 2 * N_ATT;
__device__ __forceinline__ void mixer_phase(Frame& F, int l) {
    LAS unsigned char* scr = F.lds + F.wave * WSCR; LAS float* tbl = (LAS float*)(F.lds + TBL_OFF);
    for (int e = F.tid; e < 3 * 129 * 4; e += NWAVES * 64) tbl[e] = BIAS_(F)[e];
    __syncthreads();
    gu32* head = CTL_(F) + CW_Q + 64 * l;
    for (;;) {
        int idx = 0; if (F.lane == 0) idx = (int)__hip_atomic_fetch_add(head, 1u, RLX_AGENT);
        idx = __builtin_amdgcn_readfirstlane(idx);
        if (idx >= N_ITEMS) break;
        if (idx < N_DN) { if (PH_MASK & 256) dn_item(F, l, idx >> 2, idx & 3, scr); continue; }
        idx -= N_DN;
        if (idx < N_S5) { if (PH_MASK & 512) s5_item(F, l, idx >> 4, idx & 15, scr); continue; }
        idx -= N_S5;
        const int j = idx >> 1;
        if ((idx & 1) == 0) { const int bh = j & 31, qt = 127 - (j >> 5); if (PH_MASK & 1024) mla_item(F, bh >> 2, bh & 3, qt, scr); }
        else { const int bh = j & 31, rest = j >> 5; if (PH_MASK & 2048) dil_item(F, bh >> 2, bh & 3, 7 - (rest >> 4), rest & 15, scr, tbl); }
    }
}

constexpr int N_PHASES = 1 + 7 * NL;
struct Args { const float* in[30]; float* out; unsigned char* ws; int ph_lo, ph_hi; };
__global__ void __launch_bounds__(NWAVES * 64, 2) fwd_megakernel(Args args) {
    extern __shared__ __attribute__((aligned(16))) unsigned char lds[];
    Frame F;
    F.lds = (LAS unsigned char*)lds;
    F.tid = threadIdx.x; F.lane = F.tid & 63; F.wave = __builtin_amdgcn_readfirstlane(F.tid >> 6);
    F.G = gridDim.x; { const int bx = blockIdx.x; F.vcu = (F.G % 8 == 0) ? (bx % 8) * (F.G / 8) + bx / 8 : bx; }
    F.out = args.out; F.ws = args.ws;
    if (F.tid < 30) { const unsigned long long p = (unsigned long long)args.in[F.tid]; ((LAS unsigned*)(F.lds + INP_OFF))[2 * F.tid] = (unsigned)p; ((LAS unsigned*)(F.lds + INP_OFF))[2 * F.tid + 1] = (unsigned)(p >> 32); }
    volatile LAS unsigned* MISC = (volatile LAS unsigned*)(F.lds + MISC_OFF);
    if (F.tid < 64) MISC[F.tid] = 0u;
    __syncthreads();
#if MK_MODE == 1
    cooperative_groups::grid_group grid = cooperative_groups::this_grid();
#define GRID_BAR() grid.sync()
#elif MK_MODE == 2
    XcdBarrier bar = xcd_barrier_post((unsigned*)(CTL_(F) + CW_BAR), MISC + 8);
#define GRID_BAR() xcd_barrier(bar)
#else
#define GRID_BAR() do {} while (0)
#endif
    const int lo = args.ph_lo, hi = args.ph_hi;
#define IN(p) (lo <= (p) && (p) < hi)
#define REFRESH() do { int tv = threadIdx.x; asm volatile("" : "+v"(tv)); F.tid = tv; F.lane = tv & 63; F.wave = __builtin_amdgcn_readfirstlane(tv >> 6); \
        unsigned long long wv = (unsigned long long)args.ws, ov = (unsigned long long)args.out; asm volatile("" : "+s"(wv), "+s"(ov)); F.ws = (unsigned char*)wv; F.out = (float*)ov; } while (0)
#define SEAM(p) do { if (IN(p) && IN((p) + 1)) GRID_BAR(); } while (0)
    if (IN(0)) { REFRESH(); if (PH_MASK & 1) p0_prologue(F); }
    SEAM(0);
#define LAYER(l) do { \
    if (IN(1 + 7 * (l)) && (PH_MASK & 2)) { REFRESH(); unsigned char* L = lw(F, l); \
        pg8::Gemm g{XB_(F), (const bf16*)(L + LW_WIN), TOK, PP, DM, DM}; pg8::StaticOrder S; S.init(TOK, PP, F.G, (int)blockIdx.x); \
        pg8::EpiRowScale E{PROJ_(F), PP, SSQ_(F) + (size_t)(2 * (l)) * TOK * 16}; \
        pg8::gemm_phase<pg8::EpiRowScale, pg8::StaticOrder, true, true>(F.lds, g, S, E); } \
    SEAM(1 + 7 * (l)); \
    if (IN(2 + 7 * (l)) && (PH_MASK & 4)) { REFRESH(); const int gw = F.vcu * NWAVES + F.wave, NGW = F.G * NWAVES; for (int t = gw; t < TOK; t += NGW) prep_token(F, l, t); } \
    SEAM(2 + 7 * (l)); \
    if (IN(3 + 7 * (l)) && (PH_MASK & 8)) { REFRESH(); mixer_phase(F, l); } \
    SEAM(3 + 7 * (l)); \
    if (IN(4 + 7 * (l)) && (PH_MASK & 16)) { REFRESH(); unsigned char* L = lw(F, l); \
        pg8::Gemm g{YS5_(F), (const bf16*)(L + LW_WGLU), TOK, 512, 256, 256}; pg8::StaticOrder S; S.init(TOK, 512, F.G, (int)blockIdx.x); \
        pg8::EpiGated<1> E{PROJ_(F) + C_US5, PP, nullptr}; \
        pg8::gemm_phase<pg8::EpiGated<1>, pg8::StaticOrder, true, true>(F.lds, g, S, E); } \
    SEAM(4 + 7 * (l)); \
    if (IN(5 + 7 * (l)) && (PH_MASK & 32)) { REFRESH(); unsigned char* L = lw(F, l); \
        pg8::Gemm g{PROJ_(F), (const bf16*)(L + LW_WOUT), TOK, DM, DM, PP}; pg8::StaticOrder S; S.init(TOK, DM, F.G, (int)blockIdx.x); \
        pg8::EpiResid E{(l) == 0 ? inp(F, 0) : F.out, F.out, XB_(F), SSQ_(F) + (size_t)(2 * (l) + 1) * TOK * 16}; \
        pg8::gemm_phase<pg8::EpiResid, pg8::StaticOrder, true, true>(F.lds, g, S, E); } \
    SEAM(5 + 7 * (l)); \
    if (IN(6 + 7 * (l)) && (PH_MASK & 64)) { REFRESH(); unsigned char* L = lw(F, l); \
        pg8::Gemm g{XB_(F), (const bf16*)(L + LW_W13), TOK, 2 * FFH, DM, DM}; pg8::StaticOrder S; S.init(TOK, 2 * FFH, F.G, (int)blockIdx.x); \
        pg8::EpiGated<0> E{PROJ_(F), FFH, SSQ_(F) + (size_t)(2 * (l) + 1) * TOK * 16}; \
        pg8::gemm_phase<pg8::EpiGated<0>, pg8::StaticOrder, true, true>(F.lds, g, S, E); } \
    SEAM(6 + 7 * (l)); \
    if (IN(7 + 7 * (l)) && (PH_MASK & 128)) { REFRESH(); unsigned char* L = lw(F, l); \
        pg8::Gemm g{PROJ_(F), (const bf16*)(L + LW_W2), TOK, DM, FFH, FFH}; pg8::StaticOrder S; S.init(TOK, DM, F.G, (int)blockIdx.x); \
        pg8::EpiResid E{F.out, F.out, XB_(F), SSQ_(F) + (size_t)(2 * (l) + 2) * TOK * 16}; \
        pg8::gemm_phase<pg8::EpiResid, pg8::StaticOrder, true, true>(F.lds, g, S, E); } \
    SEAM(7 + 7 * (l)); } while (0)
    LAYER(0);
    LAYER(1);
}

extern "C" void kernel_launch(void* const* d_in, const int* in_sizes, int n_in, void* d_out, int out_size, void* d_ws, size_t ws_size, hipStream_t stream) {
    static int grid = 0;
    if (grid == 0) {
        if (n_in != 30 || in_sizes[0] != TOK * DM || out_size != TOK * DM || ws_size < WS_END) {
            fprintf(stderr, "kernel_launch: unexpected shapes: n_in %d in0 %d out %d ws %zu (need %zu); nothing launched\n", n_in, n_in > 0 ? in_sizes[0] : -1, out_size, ws_size, (size_t)WS_END); grid = -1; return; }
        int dev = 0, cus = 0, per_cu = 0;
        if (hipGetDevice(&dev) != hipSuccess || hipDeviceGetAttribute(&cus, hipDeviceAttributeMultiprocessorCount, dev) != hipSuccess) { fprintf(stderr, "kernel_launch: device query failed\n"); grid = -1; return; }
        if (hipFuncSetAttribute((const void*)fwd_megakernel, hipFuncAttributeMaxDynamicSharedMemorySize, LDS_BYTES) != hipSuccess) { fprintf(stderr, "kernel_launch: hipFuncSetAttribute failed\n"); grid = -1; return; }
        if (hipOccupancyMaxActiveBlocksPerMultiprocessor(&per_cu, (const void*)fwd_megakernel, NWAVES * 64, LDS_BYTES) != hipSuccess || per_cu < 1) {
            fprintf(stderr, "kernel_launch: occupancy query reports %d workgroups per CU; nothing launched\n", per_cu); (void)hipGetLastError(); grid = -1; return; }
        grid = cus;
    }
    if (grid < 0) return;
    if (hipMemsetAsync((char*)d_ws + WS_CTL, 0, CTL_ZERO_BYTES, stream) != hipSuccess) { fprintf(stderr, "kernel_launch: memset failed\n"); return; }
    Args a{};
    for (int i = 0; i < 30; ++i) a.in[i] = (const float*)d_in[i];
    a.out = (float*)d_out; a.ws = (unsigned char*)d_ws;
#if MK_MODE == 0
    for (int p = 0; p < N_PHASES; ++p) { a.ph_lo = p; a.ph_hi = p + 1; hipLaunchKernelGGL(fwd_megakernel, dim3(grid), dim3(NWAVES * 64), LDS_BYTES, stream, a); }
#elif MK_MODE == 1
    a.ph_lo = 0; a.ph_hi = N_PHASES; void* kargs[] = {&a};
    hipError_t e = hipLaunchCooperativeKernel((const void*)fwd_megakernel, dim3(grid), dim3(NWAVES * 64), kargs, LDS_BYTES, stream);
    if (e != hipSuccess) fprintf(stderr, "kernel_launch: cooperative launch failed: %s (grid %d)\n", hipGetErrorString(e), grid);
#else
    a.ph_lo = 0; a.ph_hi = N_PHASES;
    hipLaunchKernelGGL(fwd_megakernel, dim3(grid), dim3(NWAVES * 64), LDS_BYTES, stream, a);
#endif
    const hipError_t le = hipPeekAtLastError();
    if (le != hipSuccess) fprintf(stderr, "kernel_launch: launch failed: %s\n", hipGetErrorName(le));
}
```

```cpp
#include <hip/hip_runtime.h>
#include <hip/hip_cooperative_groups.h>
#include <cstdio>
#include <cstdint>
#include <cmath>
#ifndef MK_MODE
#define MK_MODE 2
#endif
#ifndef PH_MASK
#define PH_MASK 0xFFFF
#endif

namespace pg8 {
#define PG8_LAS __attribute__((address_space(3)))
typedef unsigned short bf16_t;
typedef short bf16x8 __attribute__((ext_vector_type(8)));
typedef float f32x4 __attribute__((ext_vector_type(4)));
typedef unsigned u32x4 __attribute__((ext_vector_type(4)));
constexpr int BM = 256, BK = 64, HALF = 128, HTB = HALF * BK * 2  , STAGE_BYTES = 8 * HTB, NXCD = 8, WGM = 8;

__host__ __device__ __forceinline__ int lds_byte(int r, int c) { const int st = (r >> 4) * 2 + (c >> 5), rr = r & 15, cc = c & 31, ob = rr * 64 + cc * 2; return st * 1024 + (ob ^ (((ob >> 9) & 1) << 5)); }
__host__ __device__ __forceinline__ void stage_rc(int b, int& R, int& C) { const int st = b / 1024, sb = b % 1024, swz = sb ^ (((sb >> 9) & 1) << 5); R = (st >> 1) * 16 + swz / 64; C = (st & 1) * 32 + (swz % 64) / 2; }
__host__ __device__ __forceinline__ int perm32(int rho) { const int n = rho >> 4, i = rho & 15; return 8 * (i >> 2) + 4 * n + (i & 3); }

struct Unit { int pm, pn; };
struct Gemm { const bf16_t* A; const bf16_t* Bt; int M, N, K, lda; };

struct StaticOrder {
    int nM, nN, nwg, G, c;
    __host__ __device__ void init(int M, int N, int G_, int c_) { nM = M / BM; nN = N / BM; nwg = nM * nN; G = G_; c = c_; }
    __host__ __device__ bool next(int i, Unit& u) const {
        const long L = (long)i * G + c; if (L >= nwg) return false;
        int wgid = (int)L; { const int q = nwg / NXCD, r = nwg % NXCD, xcd = wgid % NXCD, off = wgid / NXCD; wgid = (xcd < r ? xcd * (q + 1) : r * (q + 1) + (xcd - r) * q) + off; }
        const int nig = WGM * nN, gid = wgid / nig, fm = gid * WGM, gsz = (nM - fm) < WGM ? (nM - fm) : WGM;
        u.pm = fm + ((wgid % nig) % gsz); u.pn = (wgid % nig) / gsz; return true;
    }
    __device__ __forceinline__ void a_ready(const Unit&) const {}
    __device__ __forceinline__ void done(const Unit&) const {}
};

__device__ __forceinline__ unsigned cvt_pk_bf16(float lo, float hi) { unsigned r; asm volatile("v_cvt_pk_bf16_f32 %0, %1, %2" : "=v"(r) : "v"(lo), "v"(hi)); return r; }
__device__ __forceinline__ float row_rs(const float* ssq, int row) {
    const f32x4* p = (const f32x4*)(ssq + (size_t)row * 16); const f32x4 a = p[0], b = p[1], c = p[2], d = p[3];
    const float s = ((a[0] + a[1]) + (a[2] + a[3])) + ((b[0] + b[1]) + (b[2] + b[3])) + ((c[0] + c[1]) + (c[2] + c[3])) + ((d[0] + d[1]) + (d[2] + d[3]));
    return 1.0f / sqrtf(s * (1.0f / 1024.0f) + 1e-6f);
}
struct EpiRowScale {
    static constexpr bool PERM = true, AFTER_DRAIN = false;
    bf16_t* O; int ldc; const float* ssq;
    __device__ __forceinline__ void operator()(const f32x4 (&acc)[2][2][4][2], const Unit& u, int wr, int wc, int fr, int fq) const {
        const int row0 = u.pm * BM + wr * 64 + fr, col0 = u.pn * BM + wc * 32 + 8 * fq;
#pragma unroll
        for (int ai = 0; ai < 2; ++ai)
#pragma unroll
            for (int m = 0; m < 4; ++m) { const int row = row0 + ai * HALF + m * 16; const float rs = row_rs(ssq, row); bf16_t* rowp = O + (size_t)row * ldc + col0;
#pragma unroll
                for (int bj = 0; bj < 2; ++bj) { const f32x4 v0 = acc[ai][bj][m][0] * rs, v1 = acc[ai][bj][m][1] * rs;
                    u32x4 w; w.x = cvt_pk_bf16(v0[0], v0[1]); w.y = cvt_pk_bf16(v0[2], v0[3]); w.z = cvt_pk_bf16(v1[0], v1[1]); w.w = cvt_pk_bf16(v1[2], v1[3]);
                    *(u32x4*)(rowp + bj * HALF) = w; } }
    }
};
template <int mode> struct EpiGated {
    static constexpr bool PERM = true, AFTER_DRAIN = false;
    bf16_t* O; int ldc; const float* ssq;
    __device__ __forceinline__ void operator()(const f32x4 (&acc)[2][2][4][2], const Unit& u, int wr, int wc, int fr, int fq) const {
        const int row0 = u.pm * BM + wr * 64 + fr, col0 = u.pn * HALF + wc * 32 + 8 * fq;
#pragma unroll
        for (int ai = 0; ai < 2; ++ai)
#pragma unroll
            for (int m = 0; m < 4; ++m) { const int row = row0 + ai * HALF + m * 16; const float rs = (mode == 0) ? row_rs(ssq, row) : 1.0f;
                float o[8];
#pragma unroll
                for (int n = 0; n < 2; ++n)
#pragma unroll
                    for (int j = 0; j < 4; ++j) { const float a = acc[ai][0][m][n][j] * rs, b = acc[ai][1][m][n][j] * rs;
                        const float x = (mode == 0) ? a : b; const float sg = 1.0f / (1.0f + __expf(-x));
                        o[n * 4 + j] = (mode == 0) ? (a * sg) * b : a * sg; }
                u32x4 w; w.x = cvt_pk_bf16(o[0], o[1]); w.y = cvt_pk_bf16(o[2], o[3]); w.z = cvt_pk_bf16(o[4], o[5]); w.w = cvt_pk_bf16(o[6], o[7]);
                *(u32x4*)(O + (size_t)row * ldc + col0) = w; }
    }
};
struct EpiResid {
    static constexpr bool PERM = true, AFTER_DRAIN = false;
    const float* hin; float* hout; bf16_t* xb; float* ssq;
    __device__ __forceinline__ void operator()(const f32x4 (&acc)[2][2][4][2], const Unit& u, int wr, int wc, int fr, int fq) const {
        const int row0 = u.pm * BM + wr * 64 + fr, col0 = u.pn * BM + wc * 32 + 8 * fq;
#pragma unroll
        for (int ai = 0; ai < 2; ++ai)
#pragma unroll
            for (int m = 0; m < 4; ++m) { const int row = row0 + ai * HALF + m * 16; const size_t off = (size_t)row * 1024 + col0; float sq = 0.f;
#pragma unroll
                for (int bj = 0; bj < 2; ++bj) {
                    const f32x4 h0 = *(const f32x4*)(hin + off + bj * HALF) + acc[ai][bj][m][0], h1 = *(const f32x4*)(hin + off + bj * HALF + 4) + acc[ai][bj][m][1];
                    *(f32x4*)(hout + off + bj * HALF) = h0; *(f32x4*)(hout + off + bj * HALF + 4) = h1;
                    u32x4 w; w.x = cvt_pk_bf16(h0[0], h0[1]); w.y = cvt_pk_bf16(h0[2], h0[3]); w.z = cvt_pk_bf16(h1[0], h1[1]); w.w = cvt_pk_bf16(h1[2], h1[3]);
                    *(u32x4*)(xb + off + bj * HALF) = w;
                    sq += (h0[0] * h0[0] + h0[1] * h0[1]) + (h0[2] * h0[2] + h0[3] * h0[3]) + (h1[0] * h1[0] + h1[1] * h1[1]) + (h1[2] * h1[2] + h1[3] * h1[3]); }
                sq += __shfl_xor(sq, 16); sq += __shfl_xor(sq, 32);
                if (fq == 0) ssq[(size_t)row * 16 + u.pn * 4 + wc] = sq; }
    }
};

template <class Epi, class Sched, bool ALIGN_EPI = false, bool SP2 = false>
__device__ __forceinline__ void gemm_phase(PG8_LAS unsigned char* lds, const Gemm g, const Sched& S, const Epi& E) {
    int tid_ = threadIdx.x; asm volatile("" : "+v"(tid_)); const int tid = tid_, wid = __builtin_amdgcn_readfirstlane(tid >> 6), lane = tid & 63, wr = wid >> 2, wc = wid & 3, fr = lane & 15, fq = lane >> 4;
    int K_ = g.K; asm volatile("" : "+s"(K_)); const int K = K_, nt = K / BK;
    unsigned voffA[2], voffB[2];
#pragma unroll
    for (int i = 0; i < 2; ++i) { int R, C; stage_rc(tid * 16 + i * 8192, R, C); const int Rb = Epi::PERM ? ((R & ~31) + perm32(R & 31)) : R;
        voffA[i] = (unsigned)(R * g.lda + C) * 2u; voffB[i] = (unsigned)(Rb * K + C) * 2u; }
    const size_t kstep = (size_t)(BK * 2);
    const size_t hstepB = (size_t)HALF * K * 2, hstepA = (size_t)HALF * g.lda * 2;
    const size_t tstepB = 2 * hstepB, tstepA = 2 * hstepA;
    const unsigned ldsw = (unsigned)wid * 1024u;
    const int aoff = lds_byte(wr * 64 + fr, fq * 8), boff = lds_byte(wc * 32 + fr, fq * 8);
#define PG8_SA(b, h) (((b) * 2 + (h)) * HTB)
#define PG8_SB(b, h) ((4 + (b) * 2 + (h)) * HTB)
#define PG8_STAGE(bufoff, gbase, voff) do { _Pragma("unroll") for (int _i = 0; _i < 2; ++_i) \
        __builtin_amdgcn_global_load_lds((const unsigned*)((const char*)(gbase) + (voff)[_i]), (PG8_LAS unsigned*)(lds + (bufoff) + ldsw + _i * 8192), 16, 0, 0); } while (0)
#define PG8_LDA(dst, b, h) do { _Pragma("unroll") for (int m = 0; m < 4; ++m) _Pragma("unroll") for (int k = 0; k < 2; ++k) dst[m][k] = *(const PG8_LAS bf16x8*)(lds + PG8_SA(b, h) + aoff + m * 2048 + k * 1024); } while (0)
#define PG8_LDB(dst, b, h) do { _Pragma("unroll") for (int n = 0; n < 2; ++n) _Pragma("unroll") for (int k = 0; k < 2; ++k) dst[n][k] = *(const PG8_LAS bf16x8*)(lds + PG8_SB(b, h) + boff + n * 2048 + k * 1024); } while (0)
#define PG8_MMA(ai, bj, At, Bt) do { __builtin_amdgcn_s_setprio(1); _Pragma("unroll") for (int m = 0; m < 4; ++m) _Pragma("unroll") for (int n = 0; n < 2; ++n) _Pragma("unroll") for (int k = 0; k < 2; ++k) \
        acc[ai][bj][m][n] = __builtin_amdgcn_mfma_f32_16x16x32_bf16(Bt[n][k], At[m][k], acc[ai][bj][m][n], 0, 0, 0); __builtin_amdgcn_s_setprio(0); } while (0)
#define PG8_WAIT_V(n) asm volatile("s_waitcnt vmcnt(" #n ")" ::: "memory")
#define PG8_WAIT_L(n) asm volatile("s_waitcnt lgkmcnt(" #n ")" ::: "memory")
#define PG8_BAR __builtin_amdgcn_s_barrier()
#define PG8_SCHED __builtin_amdgcn_sched_barrier(0)
    Unit cur, nxt; int ui = 0;
    if (!S.next(0, cur)) return;
    f32x4 acc[2][2][4][2];
#pragma unroll
    for (int a = 0; a < 2; ++a)
#pragma unroll
        for (int b = 0; b < 2; ++b)
#pragma unroll
            for (int m = 0; m < 4; ++m)
#pragma unroll
                for (int n = 0; n < 2; ++n) acc[a][b][m][n] = (f32x4){0.f, 0.f, 0.f, 0.f};
    bf16x8 At[4][2], B0[2][2], B1[2][2];
    const char* cA = (const char*)g.A + (size_t)cur.pm * tstepA; const char* cB = (const char*)g.Bt + (size_t)cur.pn * tstepB;
    S.a_ready(cur);
    if constexpr (SP2) {
        PG8_STAGE(PG8_SB(0, 0), cB, voffB); PG8_STAGE(PG8_SB(0, 1), cB + hstepB, voffB); PG8_STAGE(PG8_SA(0, 0), cA, voffA); PG8_STAGE(PG8_SA(0, 1), cA + hstepA, voffA);
        if (wr == 1) PG8_BAR;
        PG8_WAIT_V(2); PG8_BAR;
        PG8_STAGE(PG8_SB(1, 0), cB + kstep, voffB); PG8_STAGE(PG8_SA(1, 0), cA + kstep, voffA); PG8_STAGE(PG8_SB(1, 1), cB + hstepB + kstep, voffB);
        PG8_WAIT_V(6); PG8_BAR;
    } else {
        PG8_STAGE(PG8_SB(0, 0), cB, voffB); PG8_STAGE(PG8_SA(0, 0), cA, voffA); PG8_STAGE(PG8_SB(0, 1), cB + hstepB, voffB); PG8_STAGE(PG8_SA(0, 1), cA + hstepA, voffA);
        if (wr == 1) PG8_BAR;
        PG8_WAIT_V(4); PG8_BAR;
        PG8_STAGE(PG8_SB(1, 0), cB + kstep, voffB); PG8_STAGE(PG8_SA(1, 0), cA + kstep, voffA); PG8_STAGE(PG8_SB(1, 1), cB + hstepB + kstep, voffB);
        PG8_WAIT_V(6); PG8_BAR;
    }
    for (;;) {
        const bool has_next = S.next(ui + 1, nxt);
        const char* nA = has_next ? (const char*)g.A + (size_t)nxt.pm * tstepA : cA; const char* nB = has_next ? (const char*)g.Bt + (size_t)nxt.pn * tstepB : cB;
        for (int t = 0; t < nt; t += 2) {
            const bool last = (t == nt - 2);
            const char* a1 = cA + (size_t)(t + 1) * kstep;
            const char* a2 = last ? nA : cA + (size_t)(t + 2) * kstep; const char* b2 = last ? nB : cB + (size_t)(t + 2) * kstep;
            const char* a3 = a2 + kstep; const char* b3 = b2 + kstep;
            if (last && has_next) S.a_ready(nxt);
            if constexpr (SP2) {
            PG8_LDB(B0, 0, 0); PG8_LDB(B1, 0, 1); PG8_SCHED; PG8_LDA(At, 0, 0); PG8_STAGE(PG8_SA(1, 1), a1 + hstepA, voffA);
            PG8_WAIT_V(8); PG8_WAIT_L(0); PG8_BAR; PG8_MMA(0, 0, At, B0); PG8_MMA(0, 1, At, B1); PG8_BAR; PG8_SCHED;
            PG8_LDA(At, 0, 1); PG8_STAGE(PG8_SB(0, 0), b2, voffB); PG8_STAGE(PG8_SB(0, 1), b2 + hstepB, voffB); PG8_STAGE(PG8_SA(0, 0), a2, voffA);
            PG8_WAIT_V(8); PG8_WAIT_L(0); PG8_BAR; PG8_MMA(1, 0, At, B0); PG8_MMA(1, 1, At, B1); PG8_BAR; PG8_SCHED;
            PG8_LDB(B0, 1, 0); PG8_LDB(B1, 1, 1); PG8_SCHED; PG8_LDA(At, 1, 0); PG8_STAGE(PG8_SA(0, 1), a2 + hstepA, voffA);
            PG8_WAIT_V(8); PG8_WAIT_L(0); PG8_BAR; PG8_MMA(0, 0, At, B0); PG8_MMA(0, 1, At, B1); PG8_BAR; PG8_SCHED;
            PG8_LDA(At, 1, 1); PG8_STAGE(PG8_SB(1, 0), b3, voffB); PG8_STAGE(PG8_SB(1, 1), b3 + hstepB, voffB); PG8_STAGE(PG8_SA(1, 0), a3, voffA);
            PG8_WAIT_V(8); PG8_WAIT_L(0); PG8_BAR; PG8_MMA(1, 0, At, B0); PG8_MMA(1, 1, At, B1); PG8_BAR; PG8_SCHED;
            } else {
            PG8_LDB(B0, 0, 0); PG8_SCHED; PG8_LDA(At, 0, 0); PG8_STAGE(PG8_SA(1, 1), a1 + hstepA, voffA);
            PG8_WAIT_L(8); PG8_BAR; PG8_WAIT_L(0); PG8_MMA(0, 0, At, B0); PG8_BAR; PG8_SCHED;
            PG8_LDB(B1, 0, 1); PG8_STAGE(PG8_SB(0, 0), b2, voffB);
            PG8_BAR; PG8_WAIT_L(0); PG8_MMA(0, 1, At, B1); PG8_BAR;
            PG8_LDA(At, 0, 1); PG8_STAGE(PG8_SA(0, 0), a2, voffA);
            PG8_BAR; PG8_WAIT_L(0); PG8_MMA(1, 0, At, B0); PG8_BAR; PG8_SCHED;
            PG8_STAGE(PG8_SB(0, 1), b2 + hstepB, voffB);
            PG8_WAIT_V(6); PG8_BAR; PG8_MMA(1, 1, At, B1); PG8_BAR;
            PG8_LDB(B0, 1, 0); PG8_SCHED; PG8_LDA(At, 1, 0); PG8_STAGE(PG8_SA(0, 1), a2 + hstepA, voffA);
            PG8_WAIT_L(8); PG8_BAR; PG8_WAIT_L(0); PG8_MMA(0, 0, At, B0); PG8_BAR; PG8_SCHED;
            PG8_LDB(B1, 1, 1); PG8_STAGE(PG8_SB(1, 0), b3, voffB);
            PG8_BAR; PG8_WAIT_L(0); PG8_MMA(0, 1, At, B1); PG8_BAR;
            PG8_LDA(At, 1, 1); PG8_STAGE(PG8_SA(1, 0), a3, voffA);
            PG8_BAR; PG8_WAIT_L(0); PG8_MMA(1, 0, At, B0); PG8_BAR; PG8_SCHED;
            PG8_STAGE(PG8_SB(1, 1), b3 + hstepB, voffB);
            PG8_WAIT_V(6); PG8_BAR; PG8_MMA(1, 1, At, B1); PG8_BAR;
            }
        }
        if constexpr (ALIGN_EPI) { if (wr == 0) PG8_BAR; }
        if constexpr (!Epi::AFTER_DRAIN) { E(acc, cur, wr, wc, fr, fq); S.done(cur); }
        if (!has_next) break;
#pragma unroll
        for (int a = 0; a < 2; ++a)
#pragma unroll
            for (int b = 0; b < 2; ++b)
#pragma unroll
                for (int m = 0; m < 4; ++m)
#pragma unroll
                    for (int n = 0; n < 2; ++n) acc[a][b][m][n] = (f32x4){0.f, 0.f, 0.f, 0.f};
        cur = nxt; cA = nA; cB = nB; ++ui;
        if constexpr (ALIGN_EPI) { if (wr == 1) PG8_BAR; }
    }
    PG8_WAIT_V(0);
    if constexpr (!ALIGN_EPI) { if (wr == 0) PG8_BAR; }
    PG8_BAR;
    if constexpr (Epi::AFTER_DRAIN) { E.fused(acc, cur, wr, wc, fr, fq, lds, wid, lane); S.done(cur); }
#undef PG8_SA
#undef PG8_SB
#undef PG8_STAGE
#undef PG8_LDA
#undef PG8_LDB
#undef PG8_MMA
#undef PG8_WAIT_V
#undef PG8_WAIT_L
#undef PG8_BAR
#undef PG8_SCHED
}
}


constexpr int NWAVES = 8;
constexpr int NB = 8, SEQ = 2048, TOK = NB * SEQ, DM = 1024, NL = 2;
constexpr int INC = 2472;
constexpr int PP = 3584;
constexpr int FFH = 2816;
constexpr float EPS = 1e-6f;
constexpr float LOG2E = 1.4426950408889634f;
constexpr int C_CQ = 0;
constexpr int C_US5 = 256;
constexpr int C_DQ = 512;
constexpr int C_GATE = 768;
constexpr int C_DK = 1024, C_DV = 1280;
constexpr int C_MQ = 1536;
constexpr int C_MKV = 1920;
constexpr int C_CKV = 2432;
constexpr int C_DN = 2560;
constexpr int C_KR = 3328;
constexpr int C_A = 3360, C_B = 3364;

constexpr size_t WS_CTL = 0, CTL_ZERO_BYTES = 1u << 20;
constexpr size_t SZ_WIN = (size_t)PP * DM * 2, SZ_WOUT = (size_t)DM * DM * 2, SZ_W13 = (size_t)2 * FFH * DM * 2, SZ_W2 = (size_t)DM * FFH * 2, SZ_WGLU = (size_t)512 * 256 * 2;
constexpr size_t SZ_AB = 16 * 64 * 2 * 4, SZ_BB = 16 * 64 * 16 * 2 * 4;
constexpr size_t LW_WIN = 0, LW_WOUT = LW_WIN + SZ_WIN, LW_W13 = LW_WOUT + SZ_WOUT, LW_W2 = LW_W13 + SZ_W13, LW_WGLU = LW_W2 + SZ_W2, LW_AB = LW_WGLU + SZ_WGLU, LW_BB = LW_AB + SZ_AB, LW_SIZE = LW_BB + SZ_BB;
constexpr size_t WS_LW = 1u << 20;
constexpr size_t WS_BIAS = WS_LW + NL * LW_SIZE;
constexpr size_t WS_XB = WS_BIAS + 8192;
constexpr size_t WS_SSQ = WS_XB + (size_t)TOK * DM * 2;
constexpr size_t SZ_SSQ = (size_t)TOK * 16 * 4;
constexpr size_t WS_PROJ = WS_SSQ + 5 * SZ_SSQ;
constexpr size_t WS_DNC = WS_PROJ + (size_t)TOK * PP * 2;
constexpr size_t WS_DG = WS_DNC + (size_t)1024 * 20480 * 2;
constexpr size_t WS_YS5 = WS_DG + 4096;
constexpr size_t WS_END = WS_YS5 + (size_t)TOK * 256 * 2;
static_assert(WS_END <= 268435456ull, "d_ws map must fit 256 MiB");
static_assert(WS_LW % 256 == 0 && LW_SIZE % 256 == 0 && WS_XB % 256 == 0 && WS_PROJ % 256 == 0, "alignment");
constexpr int CW_TMO = 0;
constexpr int CW_Q = 512;
constexpr int CW_BAR = 4096;

constexpr int WSCR = 18432;
constexpr int SCR_BYTES = NWAVES * WSCR;
constexpr int TBL_OFF = SCR_BYTES;
constexpr int MISC_OFF = TBL_OFF + 6400;
constexpr int INP_OFF = MISC_OFF + 256;
constexpr int LDS_BYTES = INP_OFF + 256;
static_assert(LDS_BYTES <= 160 * 1024, "LDS");

#define GAS __attribute__((address_space(1)))
#define LAS __attribute__((address_space(3)))
typedef unsigned short bf16;
typedef float f32x4 __attribute__((ext_vector_type(4)));
typedef short bf16x8 __attribute__((ext_vector_type(8)));
typedef short s16x4 __attribute__((ext_vector_type(4)));
typedef unsigned u32x4 __attribute__((ext_vector_type(4)));
typedef unsigned u32x2 __attribute__((ext_vector_type(2)));
typedef GAS unsigned gu32;
#define RLX_AGENT __ATOMIC_RELAXED, __HIP_MEMORY_SCOPE_AGENT
#define WAVE_FENCE() do { asm volatile("" ::: "memory"); __builtin_amdgcn_wave_barrier(); asm volatile("" ::: "memory"); } while (0)

__device__ __forceinline__ float bf_lo(unsigned u) { return __uint_as_float(u << 16); }
__device__ __forceinline__ float bf_hi(unsigned u) { return __uint_as_float(u & 0xffff0000u); }
__device__ __forceinline__ float bf2f(bf16 u) { return __uint_as_float((unsigned)u << 16); }
__device__ __forceinline__ unsigned f2bf(float f) { unsigned u = __builtin_bit_cast(unsigned, f); return (u + 0x7fffu + ((u >> 16) & 1u)) >> 16; }
__device__ __forceinline__ unsigned pk2(float lo, float hi) { return f2bf(lo) | (f2bf(hi) << 16); }
__device__ __forceinline__ float wave_sum(float v) {
#pragma unroll
    for (int o = 1; o < 64; o <<= 1) v += __shfl_xor(v, o);
    return v;
}
__device__ __forceinline__ float grp16_sum(float v) {
#pragma unroll
    for (int o = 1; o < 16; o <<= 1) v += __shfl_xor(v, o);
    return v;
}
__device__ __forceinline__ float silu_f(float x) { return x / (1.0f + __expf(-x)); }

#if MK_MODE == 2
#define XB_TMO      128
#define XB_XCNT(j)  (256  + 64 * (j))
#define XB_XSUB(j)  (1280 + 64 * (j))
#define XB_XGEN(j)  (2304 + 64 * (j))
#define XB_TOP      3328
#define XB_TOPGEN   3392
#define XCD_BAR_WORDS 3456
#define XB_SPIN_CAP (1u << 20)
__device__ __forceinline__ unsigned xb_ld(unsigned* p)              { return __hip_atomic_load(p, __ATOMIC_RELAXED, __HIP_MEMORY_SCOPE_AGENT); }
__device__ __forceinline__ unsigned xb_add(unsigned* p, unsigned v) { return __hip_atomic_fetch_add(p, v, __ATOMIC_RELAXED, __HIP_MEMORY_SCOPE_AGENT); }
__device__ __forceinline__ unsigned xb_xcc_id() { return (unsigned)__builtin_amdgcn_s_getreg((3 << 11) | 20) & 0xFu; }
#define XB_SPIN(cond, bar) do { unsigned _sp = 0; while (cond) { __builtin_amdgcn_s_sleep(1); \
    if ((++_sp & 255u) == 0u) { if (xb_ld(&(bar)[XB_TMO])) break; if (_sp > XB_SPIN_CAP) { atomicAdd(&(bar)[XB_TMO], 1u); break; } } } } while (0)
struct XcdBarrier { unsigned* bar; unsigned x; volatile LAS unsigned* st; };
__device__ __forceinline__ XcdBarrier xcd_barrier_post(unsigned* bar, volatile LAS unsigned* st) {
    XcdBarrier b; b.bar = bar; b.x = xb_xcc_id(); b.st = st;
    if (threadIdx.x == 0) (void)xb_add(&bar[XB_XCNT(b.x)], 1u);
    return b;
}
__device__ __forceinline__ void xcd_barrier_complete(unsigned* bar, unsigned x, unsigned& nloc, unsigned& nx) {
    const unsigned G = gridDim.x * gridDim.y * gridDim.z;
    unsigned sum, cnt, mine, sp = 0u;
    for (;;) {
        sum = 0u; cnt = 0u; mine = 0u;
#pragma unroll
        for (unsigned j = 0; j < 16; ++j) { const unsigned c = xb_ld(&bar[XB_XCNT(j)]); sum += c; cnt += (c > 0u) ? 1u : 0u; mine = (j == x) ? c : mine; }
        if (sum == G) break;
        __builtin_amdgcn_s_sleep(1);
        if ((++sp & 255u) == 0u) { if (xb_ld(&bar[XB_TMO])) break; if (sp > XB_SPIN_CAP) { atomicAdd(&bar[XB_TMO], 1u); break; } }
    }
    nloc = mine > 0u ? mine : 1u; nx = cnt > 0u ? cnt : 1u;
}
__device__ __forceinline__ void xcd_barrier(const XcdBarrier& b) {
    asm volatile("s_waitcnt vmcnt(0)" ::: "memory");
    __syncthreads();
    if (threadIdx.x == 0) {
        unsigned* bar = b.bar;
        __builtin_amdgcn_s_waitcnt(0);
        unsigned nloc = b.st[0], nx = b.st[1];
        if (nloc == 0u) { xcd_barrier_complete(bar, b.x, nloc, nx); b.st[0] = nloc; b.st[1] = nx; }
        const unsigned old = xb_add(&bar[XB_XSUB(b.x)], 1u);
        const unsigned gen = old / nloc;
        if (old + 1u == (gen + 1u) * nloc) {
            __builtin_amdgcn_fence(__ATOMIC_RELEASE, "agent");
            asm volatile("s_waitcnt vmcnt(0)" ::: "memory");
            const unsigned og = xb_add(&bar[XB_TOP], 1u);
            const unsigned tg = og / nx;
            if (og + 1u == (tg + 1u) * nx) xb_add(&bar[XB_TOPGEN], 1u);
            else XB_SPIN(xb_ld(&bar[XB_TOPGEN]) == tg, bar);
            __builtin_amdgcn_fence(__ATOMIC_ACQUIRE, "agent");
            xb_add(&bar[XB_XGEN(b.x)], 1u);
            asm volatile("s_waitcnt vmcnt(0)" ::: "memory");
        } else {
            XB_SPIN(xb_ld(&bar[XB_XGEN(b.x)]) == gen, bar);
            __builtin_amdgcn_fence(__ATOMIC_ACQUIRE, "agent");
            asm volatile("s_waitcnt vmcnt(0)" ::: "memory");
        }
    }
    __syncthreads();
}
#endif

struct Frame {
    LAS unsigned char* lds;
    unsigned char* ws;
    float* out;
    int tid, lane, wave, vcu, G;
};
__device__ __forceinline__ const float* inp(const Frame& F, int i) {
    const LAS unsigned* t = (const LAS unsigned*)(F.lds + INP_OFF) + 2 * i;
    const unsigned lo = __builtin_amdgcn_readfirstlane(t[0]), hi = __builtin_amdgcn_readfirstlane(t[1]);
    return (const float*)(((unsigned long long)hi << 32) | lo);
}
__device__ __forceinline__ bf16* XB_(const Frame& F) { return (bf16*)(F.ws + WS_XB); }
__device__ __forceinline__ bf16* PROJ_(const Frame& F) { return (bf16*)(F.ws + WS_PROJ); }
__device__ __forceinline__ bf16* DNC_(const Frame& F) { return (bf16*)(F.ws + WS_DNC); }
__device__ __forceinline__ bf16* YS5_(const Frame& F) { return (bf16*)(F.ws + WS_YS5); }
__device__ __forceinline__ float* SSQ_(const Frame& F) { return (float*)(F.ws + WS_SSQ); }
__device__ __forceinline__ float* DG_(const Frame& F) { return (float*)(F.ws + WS_DG); }
__device__ __forceinline__ float* BIAS_(const Frame& F) { return (float*)(F.ws + WS_BIAS); }
__device__ __forceinline__ gu32* CTL_(const Frame& F) { return (gu32*)(F.ws + WS_CTL); }
__device__ __forceinline__ unsigned char* lw(const Frame& F, int l) { return F.ws + WS_LW + (size_t)l * LW_SIZE; }

__device__ __forceinline__ void tr_item(const float* W, int ld, int srccol0, int nvalid, const float* scale, int k0, bf16* dst, int n0, int Kd, LAS float* scr, int lane) {
    const int nn = lane & 31; const bool ok = nn < nvalid;
#pragma unroll 8
    for (int i = 0; i < 32; ++i) { const int kk = 2 * i + (lane >> 5); float v = 0.f;
        if (ok) { v = W[(size_t)(k0 + kk) * ld + srccol0 + nn]; if (scale) v *= scale[k0 + kk]; }
        scr[kk * 33 + nn] = v; }
    WAVE_FENCE();
    const int c = lane & 7;
#pragma unroll
    for (int j = 0; j < 4; ++j) { const int n = (lane >> 3) + 8 * j; const LAS float* s = scr + (8 * c) * 33 + n;
        u32x4 o; o.x = pk2(s[0 * 33], s[1 * 33]); o.y = pk2(s[2 * 33], s[3 * 33]); o.z = pk2(s[4 * 33], s[5 * 33]); o.w = pk2(s[6 * 33], s[7 * 33]);
        *(u32x4*)(dst + (size_t)(n0 + n) * Kd + k0 + 8 * c) = o; }
    WAVE_FENCE();
}
__device__ __forceinline__ bool win_map(int n0, int& src, int& nvalid) {
    nvalid = 32;
    if (n0 < 256) { src = n0; return true; }
    if (n0 < 512) { src = 416 + (n0 - 256); return true; }
    if (n0 < 768) { src = 672 + (n0 - 512); return true; }
    if (n0 < 1024) { src = 2216 + (n0 - 768); return true; }
    if (n0 < 1280) { src = 928 + (n0 - 1024); return true; }
    if (n0 < 1536) { src = 1184 + (n0 - 1280); return true; }
    if (n0 < 2432) return false;
    if (n0 < 2560) { src = 256 + (n0 - 2432); return true; }
    if (n0 < 3328) { src = 1440 + (n0 - 2560); return true; }
    if (n0 < 3360) { src = 384 + (n0 - 3328); return true; }
    if (n0 < 3392) { src = 2208; nvalid = 8; return true; }
    src = 0; nvalid = 0; return true;
}
__device__ __forceinline__ void p0_prologue(Frame& F) {
    LAS float* scr = (LAS float*)(F.lds + F.wave * WSCR);
    const int gw = F.vcu * NWAVES + F.wave, NGW = F.G * NWAVES, lane = F.lane;
    constexpr int I_WIN = (PP / 32) * (DM / 64), I_WOUT = (DM / 32) * (DM / 64), I_W13 = (2 * FFH / 32) * (DM / 64), I_W2 = (DM / 32) * (FFH / 64), I_GLU = (512 / 32) * (256 / 64);
    constexpr int I_L = I_WIN + I_WOUT + I_W13 + I_W2 + I_GLU;
    for (int it = gw; it < NL * I_L; it += NGW) {
        const int l = it / I_L; int r = it % I_L; unsigned char* L = lw(F, l);
        if (r < I_WIN) { const int nb = r / (DM / 64), kb = r % (DM / 64); int src, nv; if (!win_map(32 * nb, src, nv)) continue;
            tr_item(inp(F, 2) + (size_t)l * DM * INC, INC, src, nv, inp(F, 1) + l * DM, 64 * kb, (bf16*)(L + LW_WIN), 32 * nb, DM, scr, lane); continue; }
        r -= I_WIN;
        if (r < I_WOUT) { const int nb = r / (DM / 64), kb = r % (DM / 64);
            tr_item(inp(F, 3) + (size_t)l * DM * DM, DM, 32 * nb, 32, nullptr, 64 * kb, (bf16*)(L + LW_WOUT), 32 * nb, DM, scr, lane); continue; }
        r -= I_WOUT;
        if (r < I_W13) { const int nb = r / (DM / 64), kb = r % (DM / 64); const int n0 = 32 * nb, t = n0 >> 8, i = n0 & 255;
            const float* W = (i < 128 ? inp(F, 27) : inp(F, 28)) + (size_t)l * DM * FFH;
            tr_item(W, FFH, 128 * t + (i & 127), 32, inp(F, 26) + l * DM, 64 * kb, (bf16*)(L + LW_W13), n0, DM, scr, lane); continue; }
        r -= I_W13;
        if (r < I_W2) { const int nb = r / (FFH / 64), kb = r % (FFH / 64);
            tr_item(inp(F, 29) + (size_t)l * FFH * DM, DM, 32 * nb, 32, nullptr, 64 * kb, (bf16*)(L + LW_W2), 32 * nb, FFH, scr, lane); continue; }
        r -= I_W2;
        { const int nb = r / 4, kb = r % 4; const int n0 = 32 * nb, t = n0 >> 8, i = n0 & 255;
            tr_item(inp(F, 18) + (size_t)l * 256 * 512, 512, (i < 128 ? 0 : 256) + 128 * t + (i & 127), 32, nullptr, 64 * kb, (bf16*)(L + LW_WGLU), n0, 256, scr, lane); }
    }
    for (int it = gw; it < NL * DM * 14; it += NGW) {
        const int l = it / (DM * 14), r = it % (DM * 14), k = r / 14, ch = r % 14;
        const float* wrow = inp(F, 2) + (size_t)l * DM * INC + (size_t)k * INC; const float gk = inp(F, 1)[l * DM + k];
        bf16* WT = (bf16*)(lw(F, l) + LW_WIN);
        if (ch < 6) { const int n = 64 * ch + lane; const float* wu = inp(F, 6) + (size_t)l * 256 * 384 + n; const float* gn = inp(F, 4) + l * 256;
            float wv[4];
#pragma unroll
            for (int jj = 0; jj < 4; ++jj) wv[jj] = wrow[64 * jj + lane] * gn[64 * jj + lane];
            float acc = 0.f;
#pragma unroll
            for (int jj = 0; jj < 4; ++jj)
#pragma unroll 16
                for (int j = 0; j < 64; ++j) acc += __shfl(wv[jj], j) * wu[(size_t)(64 * jj + j) * 384];
            WT[(size_t)(C_MQ + n) * DM + k] = (bf16)f2bf(acc * gk);
        } else { const int n = 64 * (ch - 6) + lane; const float* wu = inp(F, 7) + (size_t)l * 128 * 512 + n; const float* gn = inp(F, 5) + l * 128;
            float wv[2];
#pragma unroll
            for (int jj = 0; jj < 2; ++jj) wv[jj] = wrow[256 + 64 * jj + lane] * gn[64 * jj + lane];
            float acc = 0.f;
#pragma unroll
            for (int jj = 0; jj < 2; ++jj)
#pragma unroll 16
                for (int j = 0; j < 64; ++j) acc += __shfl(wv[jj], j) * wu[(size_t)(64 * jj + j) * 512];
            WT[(size_t)(C_MKV + n) * DM + k] = (bf16)f2bf(acc * gk);
        }
    }
    for (int m = gw; m < TOK; m += NGW) {
        const f32x4* xr = (const f32x4*)(inp(F, 0) + (size_t)m * DM) + lane; float s = 0.f; u32x2* o8 = (u32x2*)(XB_(F) + (size_t)m * DM) + lane;
#pragma unroll
        for (int j = 0; j < 4; ++j) { const f32x4 v = xr[64 * j]; s += (v[0] * v[0] + v[1] * v[1]) + (v[2] * v[2] + v[3] * v[3]); u32x2 w; w.x = pk2(v[0], v[1]); w.y = pk2(v[2], v[3]); o8[64 * j] = w; }
        s = wave_sum(s);
        if (lane < 16) SSQ_(F)[(size_t)m * 16 + lane] = (lane == 0) ? s : 0.f;
    }
    for (int it = gw; it < NL * 16; it += NGW) {
        const int l = it / 16, g = it % 16, p = lane; const int gi = l * 16 + g;
        const double lr = inp(F, 10)[gi * 64 + p], li = inp(F, 11)[gi * 64 + p], dt = exp((double)inp(F, 12)[gi]);
        const double mag = exp(lr * dt), ar = mag * cos(li * dt), ai = mag * sin(li * dt), den = lr * lr + li * li, nr = ar - 1.0, ni = ai;
        const double zr = (nr * lr + ni * li) / den, zi = (ni * lr - nr * li) / den;
        float* AB = (float*)(lw(F, l) + LW_AB) + (g * 64 + p) * 2; AB[0] = (float)ar; AB[1] = (float)ai;
        float* BB = (float*)(lw(F, l) + LW_BB) + (size_t)(g * 64 + p) * 32;
        for (int c = 0; c < 16; ++c) { const double br = inp(F, 13)[((size_t)gi * 64 + p) * 16 + c], bi = inp(F, 14)[((size_t)gi * 64 + p) * 16 + c];
            BB[2 * c] = (float)(zr * br - zi * bi); BB[2 * c + 1] = (float)(zr * bi + zi * br); }
    }
    if (gw == 0) {
        for (int e = lane; e < 3 * 129; e += 64) { const int br = e / 129, delta = e % 129, dil = (br == 0) ? 1 : (br == 1 ? 4 : 16); const int dist = delta * dil;
            int bk; if (dist < 16) bk = dist; else { const float df = (float)dist; int lg = 16 + (int)(logf(df / 16.0f) / logf(128.0f) * 16.0f); bk = lg < 31 ? lg : 31; }
            for (int h = 0; h < 4; ++h) BIAS_(F)[e * 4 + h] = inp(F, 21)[bk * 4 + h] * LOG2E; }
    }
}

__device__ __forceinline__ void prep_token(Frame& F, int l, int t) {
    const int lane = F.lane, hh = lane >> 4, ii = lane & 15, s = t & (SEQ - 1);
    bf16* row = PROJ_(F) + (size_t)t * PP;
    float rs_q, rs_kv;
    { const u32x2 cq = *(const u32x2*)(row + C_CQ + 4 * lane); const float a = bf_lo(cq.x), b = bf_hi(cq.x), c = bf_lo(cq.y), d = bf_hi(cq.y);
      rs_q = 1.0f / sqrtf(wave_sum((a * a + b * b) + (c * c + d * d)) * (1.0f / 256.0f) + EPS);
      const unsigned ck = *(const unsigned*)(row + C_CKV + 2 * lane); const float e = bf_lo(ck), f = bf_hi(ck);
      rs_kv = 1.0f / sqrtf(wave_sum(e * e + f * f) * (1.0f / 128.0f) + EPS); }
    const float freq = exp2f(-(float)ii * (13.287712379549449f / 16.0f));
    float cs, sn; sincosf((float)s * freq, &sn, &cs);
    {
      bf16* qp = row + C_MQ + hh * 96; const u32x2 qn = *(const u32x2*)(qp + 4 * ii);
      float q0 = bf_lo(qn.x) * rs_q, q1 = bf_hi(qn.x) * rs_q, q2 = bf_lo(qn.y) * rs_q, q3 = bf_hi(qn.y) * rs_q, x1 = bf2f(qp[64 + ii]) * rs_q, x2 = bf2f(qp[80 + ii]) * rs_q;
      const float ss = grp16_sum((q0 * q0 + q1 * q1) + (q2 * q2 + q3 * q3) + (x1 * x1 + x2 * x2));
      const float* gq = inp(F, 8) + l * 96; const float rn = (1.0f / sqrtf(ss * (1.0f / 96.0f) + EPS)) * (0.10206207261596577f * LOG2E);
      q0 *= rn * gq[4 * ii]; q1 *= rn * gq[4 * ii + 1]; q2 *= rn * gq[4 * ii + 2]; q3 *= rn * gq[4 * ii + 3]; x1 *= rn * gq[64 + ii]; x2 *= rn * gq[80 + ii];
      u32x2 w; w.x = pk2(q0, q1); w.y = pk2(q2, q3); *(u32x2*)(qp + 4 * ii) = w;
      qp[64 + ii] = (bf16)f2bf(x1 * cs - x2 * sn); qp[80 + ii] = (bf16)f2bf(x1 * sn + x2 * cs); }
    {
      bf16* kp = row + C_MKV + hh * 128; const u32x2 kn = *(const u32x2*)(kp + 4 * ii); const u32x2 vv = *(const u32x2*)(kp + 64 + 4 * ii);
      float k0 = bf_lo(kn.x) * rs_kv, k1 = bf_hi(kn.x) * rs_kv, k2 = bf_lo(kn.y) * rs_kv, k3 = bf_hi(kn.y) * rs_kv, x1 = bf2f(row[C_KR + ii]), x2 = bf2f(row[C_KR + 16 + ii]);
      const float ss = grp16_sum((k0 * k0 + k1 * k1) + (k2 * k2 + k3 * k3) + (x1 * x1 + x2 * x2));
      const float* gk = inp(F, 9) + l * 96; const float rn = 1.0f / sqrtf(ss * (1.0f / 96.0f) + EPS);
      k0 *= rn * gk[4 * ii]; k1 *= rn * gk[4 * ii + 1]; k2 *= rn * gk[4 * ii + 2]; k3 *= rn * gk[4 * ii + 3]; x1 *= rn * gk[64 + ii]; x2 *= rn * gk[80 + ii];
      u32x2 w; w.x = pk2(k0, k1); w.y = pk2(k2, k3); *(u32x2*)(kp + 4 * ii) = w;
      u32x2 wv; wv.x = pk2(bf_lo(vv.x) * rs_kv, bf_hi(vv.x) * rs_kv); wv.y = pk2(bf_lo(vv.y) * rs_kv, bf_hi(vv.y) * rs_kv); *(u32x2*)(kp + 64 + 4 * ii) = wv;
      bf16* rp = row + C_CKV + hh * 32; rp[ii] = (bf16)f2bf(x1 * cs - x2 * sn); rp[16 + ii] = (bf16)f2bf(x1 * sn + x2 * cs); }
    { bf16* qp = row + C_DQ + hh * 64 + 4 * ii; const u32x2 qn = *(const u32x2*)qp; float a = bf_lo(qn.x), b = bf_hi(qn.x), c = bf_lo(qn.y), d = bf_hi(qn.y);
      const float* g = inp(F, 19) + l * 64 + 4 * ii; const float rn = (1.0f / sqrtf(grp16_sum((a * a + b * b) + (c * c + d * d)) * (1.0f / 64.0f) + EPS)) * (0.125f * LOG2E);
      u32x2 w; w.x = pk2(a * rn * g[0], b * rn * g[1]); w.y = pk2(c * rn * g[2], d * rn * g[3]); *(u32x2*)qp = w; }
    { bf16* kp = row + C_DK + hh * 64 + 4 * ii; const u32x2 kn = *(const u32x2*)kp; float a = bf_lo(kn.x), b = bf_hi(kn.x), c = bf_lo(kn.y), d = bf_hi(kn.y);
      const float* g = inp(F, 20) + l * 64 + 4 * ii; const float rn = 1.0f / sqrtf(grp16_sum((a * a + b * b) + (c * c + d * d)) * (1.0f / 64.0f) + EPS);
      u32x2 w; w.x = pk2(a * rn * g[0], b * rn * g[1]); w.y = pk2(c * rn * g[2], d * rn * g[3]); *(u32x2*)kp = w; }
}

constexpr int VP = 144;
__device__ __forceinline__ s16x4 tr_read(const LAS unsigned char* p) {
    typedef short v4i16_t __attribute__((ext_vector_type(4)));
    return __builtin_bit_cast(s16x4, __builtin_amdgcn_ds_read_tr16_b64_v4i16((LAS v4i16_t*)p));
}
__device__ __forceinline__ unsigned cvtpk(float lo, float hi) { typedef float f2 __attribute__((ext_vector_type(2))); typedef __bf16 b2 __attribute__((ext_vector_type(2))); f2 v = {lo, hi}; return __builtin_bit_cast(unsigned, __builtin_convertvector(v, b2)); }
template <int NKS, class MB>
__device__ __forceinline__ void attn_core(const bf16x8 (&qf)[NKS], const bf16x8 (&kf)[2][NKS], const u32x4 (&vr)[4], const MB& mb, LAS unsigned char* vl, int lane, float& m, float& l, f32x4 (&o)[4]) {
    f32x4 s0 = {0.f, 0.f, 0.f, 0.f}, s1 = {0.f, 0.f, 0.f, 0.f};
#pragma unroll
    for (int ks = 0; ks < NKS; ++ks) { s0 = __builtin_amdgcn_mfma_f32_16x16x32_bf16(kf[0][ks], qf[ks], s0, 0, 0, 0); s1 = __builtin_amdgcn_mfma_f32_16x16x32_bf16(kf[1][ks], qf[ks], s1, 0, 0, 0); }
    mb(s0, s1);
    float mx = fmaxf(fmaxf(fmaxf(s0[0], s0[1]), fmaxf(s0[2], s0[3])), fmaxf(fmaxf(s1[0], s1[1]), fmaxf(s1[2], s1[3])));
    mx = fmaxf(mx, __shfl_xor(mx, 16)); mx = fmaxf(mx, __shfl_xor(mx, 32));
    const float mn = fmaxf(m, mx), alpha = __builtin_amdgcn_exp2f(m - mn); m = mn;
    float p0[4], p1[4], ps = 0.f;
#pragma unroll
    for (int i = 0; i < 4; ++i) { p0[i] = __builtin_amdgcn_exp2f(s0[i] - mn); p1[i] = __builtin_amdgcn_exp2f(s1[i] - mn); ps += p0[i] + p1[i]; }
    l = l * alpha + ps;
#pragma unroll
    for (int dt = 0; dt < 4; ++dt) o[dt] = o[dt] * alpha;
    WAVE_FENCE();
#pragma unroll
    for (int it = 0; it < 4; ++it) *(LAS u32x4*)(vl + ((lane >> 3) + 8 * it) * VP + (lane & 7) * 16) = vr[it];
    WAVE_FENCE();
    u32x4 pw; pw.x = cvtpk(p0[0], p0[1]); pw.y = cvtpk(p0[2], p0[3]); pw.z = cvtpk(p1[0], p1[1]); pw.w = cvtpk(p1[2], p1[3]);
    const bf16x8 pB = __builtin_bit_cast(bf16x8, pw);
    const int g = lane >> 4, i16 = lane & 15; const LAS unsigned char* vb = vl + (4 * g + (i16 >> 2)) * VP + (i16 & 3) * 8;
#pragma unroll
    for (int dt = 0; dt < 4; ++dt) { const s16x4 lo = tr_read(vb + dt * 32), hi = tr_read(vb + 16 * VP + dt * 32);
        const bf16x8 a = {lo[0], lo[1], lo[2], lo[3], hi[0], hi[1], hi[2], hi[3]};
        o[dt] = __builtin_amdgcn_mfma_f32_16x16x32_bf16(a, pB, o[dt], 0, 0, 0); }
    WAVE_FENCE();
}
struct MlaMask { int key0, qpos, q4;
    __device__ __forceinline__ void operator()(f32x4& s0, f32x4& s1) const {
#pragma unroll
        for (int i = 0; i < 4; ++i) { if (key0 + q4 + i > qpos) s0[i] = -INFINITY; if (key0 + 16 + q4 + i > qpos) s1[i] = -INFINITY; } } };
struct DilMask { int pq, kbase, q4, h; const LAS float* tbl;
    __device__ __forceinline__ void operator()(f32x4& s0, f32x4& s1) const {
#pragma unroll
        for (int i = 0; i < 4; ++i) {
            { const int pk = kbase + q4 + i, d = pq - pk; const int dc = d < 0 ? 0 : (d > 128 ? 128 : d); const float b = tbl[dc * 4 + h]; s0[i] = (d >= 0 && d <= 128 && pk >= 0) ? s0[i] + b : -INFINITY; }
            { const int pk = kbase + 16 + q4 + i, d = pq - pk; const int dc = d < 0 ? 0 : (d > 128 ? 128 : d); const float b = tbl[dc * 4 + h]; s1[i] = (d >= 0 && d <= 128 && pk >= 0) ? s1[i] + b : -INFINITY; } } } };

__device__ __forceinline__ void mla_item(Frame& F, int b, int h, int qt, LAS unsigned char* scr) {
    const int lane = F.lane, r = lane & 15, q = lane >> 4; const size_t rowbase = (size_t)b * SEQ; const int q0 = qt * 16;
    const bf16* P = PROJ_(F);
    bf16x8 qf[3];
    { const bf16* qp = P + (rowbase + q0 + r) * PP + C_MQ + h * 96 + 8 * q;
#pragma unroll
      for (int ks = 0; ks < 3; ++ks) qf[ks] = *(const bf16x8*)(qp + 32 * ks); }
    float m = -1e30f, l = 0.f; f32x4 o[4];
#pragma unroll
    for (int dt = 0; dt < 4; ++dt) o[dt] = (f32x4){0.f, 0.f, 0.f, 0.f};
    const int nst = (q0 + 15) / 32 + 1;
    for (int st = 0; st < nst; ++st) { const int key0 = 32 * st;
        bf16x8 kf[2][3]; u32x4 vr[4];
#pragma unroll
        for (int t = 0; t < 2; ++t) { const bf16* kr = P + (rowbase + key0 + 16 * t + r) * PP;
            kf[t][0] = *(const bf16x8*)(kr + C_MKV + h * 128 + 8 * q); kf[t][1] = *(const bf16x8*)(kr + C_MKV + h * 128 + 32 + 8 * q); kf[t][2] = *(const bf16x8*)(kr + C_CKV + h * 32 + 8 * q); }
#pragma unroll
        for (int it = 0; it < 4; ++it) vr[it] = *(const u32x4*)(P + (rowbase + key0 + (lane >> 3) + 8 * it) * PP + C_MKV + h * 128 + 64 + (lane & 7) * 8);
        const MlaMask mb{key0, q0 + r, 4 * q};
        attn_core<3, MlaMask>(qf, kf, vr, mb, scr, lane, m, l, o);
    }
    l += __shfl_xor(l, 16); l += __shfl_xor(l, 32); const float il = 1.0f / l;
    bf16* op = PROJ_(F) + (rowbase + q0 + r) * PP + C_CQ + h * 64 + 4 * q;
#pragma unroll
    for (int dt = 0; dt < 4; ++dt) { u32x2 w; w.x = pk2(o[dt][0] * il, o[dt][1] * il); w.y = pk2(o[dt][2] * il, o[dt][3] * il); *(u32x2*)(op + 16 * dt) = w; }
}
__device__ __forceinline__ void dil_item(Frame& F, int b, int h, int blk, int r16, LAS unsigned char* scr, const LAS float* tbl) {
    const int lane = F.lane, r = lane & 15, q = lane >> 4; const size_t rowbase = (size_t)b * SEQ; const int t0 = 256 * blk + r16;
    const bf16* P = PROJ_(F);
    bf16x8 qf[2];
    { const bf16* qp = P + (rowbase + t0 + 16 * r) * PP + C_DQ + h * 64 + 8 * q; qf[0] = *(const bf16x8*)qp; qf[1] = *(const bf16x8*)(qp + 32); }
    float m = -1e30f, l = 0.f; f32x4 o[4];
#pragma unroll
    for (int dt = 0; dt < 4; ++dt) o[dt] = (f32x4){0.f, 0.f, 0.f, 0.f};
    for (int br = 0; br < 3; ++br) {
        const int dil = (br == 0) ? 1 : (br == 1 ? 4 : 16), L = SEQ / dil, rd = t0 & (dil - 1), qstep = 16 / dil;
        const int pq0 = (t0 - rd) / dil;
        const int plo = pq0 - 128 < 0 ? 0 : pq0 - 128, phi = pq0 + qstep * 15;
        const int nst = (phi - plo) / 32 + 1;
        for (int st = 0; st < nst; ++st) { const int kb = plo + 32 * st;
            bf16x8 kf[2][2]; u32x4 vr[4];
#pragma unroll
            for (int t = 0; t < 2; ++t) { int pk = kb + 16 * t + r; pk = pk > L - 1 ? L - 1 : pk; const bf16* kr = P + (rowbase + rd + (size_t)dil * pk) * PP + C_DK + h * 64 + 8 * q;
                kf[t][0] = *(const bf16x8*)kr; kf[t][1] = *(const bf16x8*)(kr + 32); }
#pragma unroll
            for (int it = 0; it < 4; ++it) { int pk = kb + (lane >> 3) + 8 * it; pk = pk > L - 1 ? L - 1 : pk; vr[it] = *(const u32x4*)(P + (rowbase + rd + (size_t)dil * pk) * PP + C_DV + h * 64 + (lane & 7) * 8); }
            const DilMask mb{pq0 + qstep * r, kb, 4 * q, h, tbl + br * 129 * 4};
            attn_core<2, DilMask>(qf, kf, vr, mb, scr, lane, m, l, o);
        }
    }
    l += __shfl_xor(l, 16); l += __shfl_xor(l, 32); const float il = 1.0f / l;
    bf16* op = PROJ_(F) + (rowbase + t0 + 16 * r) * PP + C_DQ + h * 64 + 4 * q;
#pragma unroll
    for (int dt = 0; dt < 4; ++dt) { u32x2 w; w.x = pk2(o[dt][0] * il, o[dt][1] * il); w.y = pk2(o[dt][2] * il, o[dt][3] * il); *(u32x2*)(op + 16 * dt) = w; }
}
__device__ __forceinline__ void s5_item(Frame& F, int l, int b, int g, LAS unsigned char* scr) {
    const int lane = F.lane, tk = lane >> 2, c4 = lane & 3, gi = l * 16 + g;
    LAS float* Cs = (LAS float*)scr;
    LAS float* Hs = (LAS float*)(scr + 8192);
    LAS float* Us = (LAS float*)(scr + 16384);
    for (int c = 0; c < 16; ++c) { Cs[(lane * 16 + c) * 2] = inp(F, 15)[((size_t)gi * 16 + c) * 64 + lane]; Cs[(lane * 16 + c) * 2 + 1] = inp(F, 16)[((size_t)gi * 16 + c) * 64 + lane]; }
    const float* AB = (const float*)(lw(F, l) + LW_AB) + (g * 64 + lane) * 2; const float ar = AB[0], ai = AB[1];
    float bbr[16], bbi[16];
    { const f32x4* BB = (const f32x4*)((const float*)(lw(F, l) + LW_BB) + (size_t)(g * 64 + lane) * 32);
#pragma unroll
      for (int c2 = 0; c2 < 8; ++c2) { const f32x4 v = BB[c2]; bbr[2 * c2] = v[0]; bbi[2 * c2] = v[1]; bbr[2 * c2 + 1] = v[2]; bbi[2 * c2 + 1] = v[3]; } }
    float dsk[4];
#pragma unroll
    for (int e = 0; e < 4; ++e) dsk[e] = inp(F, 17)[l * 256 + g * 16 + 4 * c4 + e];
    float hr = 0.f, hi = 0.f;
    WAVE_FENCE();
    for (int bt = 0; bt < SEQ / 16; ++bt) { const size_t t0 = (size_t)b * SEQ + bt * 16;
        const u32x2 uu = *(const u32x2*)(PROJ_(F) + (t0 + tk) * PP + C_US5 + g * 16 + 4 * c4);
        const f32x4 uf = {bf_lo(uu.x), bf_hi(uu.x), bf_lo(uu.y), bf_hi(uu.y)};
        *(LAS f32x4*)(Us + tk * 16 + 4 * c4) = uf;
        WAVE_FENCE();
#pragma unroll 4
        for (int tok = 0; tok < 16; ++tok) {
            float xr = 0.f, xi = 0.f;
#pragma unroll
            for (int c2 = 0; c2 < 4; ++c2) { const f32x4 u = *(const LAS f32x4*)(Us + tok * 16 + 4 * c2);
#pragma unroll
                for (int e = 0; e < 4; ++e) { xr += bbr[4 * c2 + e] * u[e]; xi += bbi[4 * c2 + e] * u[e]; } }
            const float nhr = ar * hr - ai * hi + xr, nhi = ar * hi + ai * hr + xi; hr = nhr; hi = nhi;
            typedef float f2 __attribute__((ext_vector_type(2)));
            *(LAS f2*)(Hs + (tok * 64 + lane) * 2) = (f2){hr, hi};
        }
        WAVE_FENCE();
        float y[4] = {0.f, 0.f, 0.f, 0.f};
#pragma unroll 8
        for (int p = 0; p < 64; ++p) { typedef float f2 __attribute__((ext_vector_type(2)));
            const f2 hv = *(const LAS f2*)(Hs + (tk * 64 + p) * 2); const f32x4 ca = *(const LAS f32x4*)(Cs + (p * 16 + 4 * c4) * 2), cb = *(const LAS f32x4*)(Cs + (p * 16 + 4 * c4) * 2 + 4);
            y[0] += ca[0] * hv.x - ca[1] * hv.y; y[1] += ca[2] * hv.x - ca[3] * hv.y; y[2] += cb[0] * hv.x - cb[1] * hv.y; y[3] += cb[2] * hv.x - cb[3] * hv.y; }
        u32x2 w; w.x = pk2(y[0] + dsk[0] * uf[0], y[1] + dsk[1] * uf[1]); w.y = pk2(y[2] + dsk[2] * uf[2], y[3] + dsk[3] * uf[3]);
        *(u32x2*)(YS5_(F) + (t0 + tk) * 256 + g * 16 + 4 * c4) = w;
        WAVE_FENCE();
    }
}
constexpr int DN_NW = 0, DN_UT = 4096, DN_AQ = 8192, DN_QD = 12288, DN_KT = 16384, DN_CH = 20480;
__device__ __forceinline__ int pcol(int c) { return (c & 32) | (((c >> 2) & 3) << 3) | (((c >> 4) & 1) << 2) | (c & 3); }
__device__ __forceinline__ void dn_chunk_prep(Frame& F, int l, int c) {
    const int tid = F.tid, tok = tid >> 3, part = tid & 7, lane = F.lane, wave = F.wave;
    const int n = c & 31, bh = c >> 5, h = bh & 3, b = bh >> 2, s = 64 * n + tok;
    const size_t t0 = (size_t)b * SEQ + 64 * n;
    LAS bf16* Kb = (LAS bf16*)F.lds; LAS bf16* KBb = Kb + 64 * 72; LAS bf16* Qb = KBb + 64 * 72;
    LAS float* Lm = (LAS float*)(F.lds + 3 * 9216); LAS float* RH = Lm + 4096; LAS float* gcs = RH + 8192;
    bf16* CO = DNC_(F) + (size_t)c * DN_CH;
    float qkv[3][8];
    { const float* cw = inp(F, 22) + (size_t)l * 4 * 768 + h * 64 + 8 * part; const bf16* src = PROJ_(F) + (t0 + tok) * PP + C_DN + h * 64 + 8 * part;
#pragma unroll
      for (int w3 = 0; w3 < 3; ++w3) {
#pragma unroll
          for (int e = 0; e < 8; ++e) qkv[w3][e] = 0.f;
#pragma unroll
          for (int j = 0; j < 4; ++j) { if (s - 3 + j >= 0) { const u32x4 xv = *(const u32x4*)(src + (ptrdiff_t)(j - 3) * PP + w3 * 256); const f32x4 w0 = *(const f32x4*)(cw + j * 768 + w3 * 256), w1 = *(const f32x4*)(cw + j * 768 + w3 * 256 + 4);
              qkv[w3][0] += w0[0] * bf_lo(xv.x); qkv[w3][1] += w0[1] * bf_hi(xv.x); qkv[w3][2] += w0[2] * bf_lo(xv.y); qkv[w3][3] += w0[3] * bf_hi(xv.y);
              qkv[w3][4] += w1[0] * bf_lo(xv.z); qkv[w3][5] += w1[1] * bf_hi(xv.z); qkv[w3][6] += w1[2] * bf_lo(xv.w); qkv[w3][7] += w1[3] * bf_hi(xv.w); } }
          float ss = 0.f;
#pragma unroll
          for (int e = 0; e < 8; ++e) { qkv[w3][e] = silu_f(qkv[w3][e]); ss += qkv[w3][e] * qkv[w3][e]; }
          if (w3 < 2) { ss += __shfl_xor(ss, 1); ss += __shfl_xor(ss, 2); ss += __shfl_xor(ss, 4); const float sc = (1.0f / sqrtf(ss + EPS)) * (w3 == 0 ? 0.125f : 1.0f);
#pragma unroll
              for (int e = 0; e < 8; ++e) qkv[w3][e] *= sc; } }
      if (part == 0) { const bf16* row = PROJ_(F) + (t0 + tok) * PP; const float av = bf2f(row[C_A + h]), bv = bf2f(row[C_B + h]); const float xx = av + inp(F, 24)[l * 4 + h];
          const float sp = xx > 20.f ? xx : log1pf(expf(xx)); gcs[128 + tok] = -expf(inp(F, 23)[l * 4 + h]) * sp; gcs[64 + tok] = 1.0f / (1.0f + expf(-bv)); }
      u32x4 w; w.x = pk2(qkv[0][0], qkv[0][1]); w.y = pk2(qkv[0][2], qkv[0][3]); w.z = pk2(qkv[0][4], qkv[0][5]); w.w = pk2(qkv[0][6], qkv[0][7]); *(LAS u32x4*)(Qb + tok * 72 + 8 * part) = w;
      w.x = pk2(qkv[1][0], qkv[1][1]); w.y = pk2(qkv[1][2], qkv[1][3]); w.z = pk2(qkv[1][4], qkv[1][5]); w.w = pk2(qkv[1][6], qkv[1][7]); *(LAS u32x4*)(Kb + tok * 72 + 8 * part) = w; }
    __syncthreads();
    if (wave == 0) { float g = gcs[128 + lane];
#pragma unroll
        for (int o = 1; o < 64; o <<= 1) { const float t = __shfl_up(g, o); if (lane >= o) g += t; }
        gcs[lane] = g; }
    __syncthreads();
    { const float gc = gcs[tok], gl = gcs[63], beta = gcs[64 + tok], eg = __expf(gc), ek = __expf(gl - gc);
      float kb[8];
#pragma unroll
      for (int e = 0; e < 8; ++e) { kb[e] = qkv[1][e] * beta; RH[tok * 128 + 8 * part + e] = kb[e] * eg; RH[tok * 128 + 64 + 8 * part + e] = qkv[2][e] * beta; }
      u32x4 w; w.x = pk2(kb[0], kb[1]); w.y = pk2(kb[2], kb[3]); w.z = pk2(kb[4], kb[5]); w.w = pk2(kb[6], kb[7]); *(LAS u32x4*)(KBb + tok * 72 + 8 * part) = w;
      { bf16* qd = CO + DN_QD + tok * 64; u32x2 a, bq; a.x = pk2(qkv[0][0] * eg, qkv[0][1] * eg); a.y = pk2(qkv[0][2] * eg, qkv[0][3] * eg); bq.x = pk2(qkv[0][4] * eg, qkv[0][5] * eg); bq.y = pk2(qkv[0][6] * eg, qkv[0][7] * eg);
        *(u32x2*)(qd + pcol(8 * part)) = a; *(u32x2*)(qd + pcol(8 * part + 4)) = bq; }
#pragma unroll
      for (int e = 0; e < 8; ++e) CO[DN_KT + (8 * part + e) * 64 + pcol(tok)] = (bf16)f2bf(qkv[1][e] * ek);
      if (tid == 0) DG_(F)[c] = __expf(gl); }
    __syncthreads();
#pragma unroll
    for (int rep = 0; rep < 2; ++rep) { const int id = wave + 8 * rep, ti = id >> 2, tj = id & 3, r = lane & 15, q = lane >> 4;
        f32x4 kk = {0.f, 0.f, 0.f, 0.f}, qk = {0.f, 0.f, 0.f, 0.f};
        if (tj <= ti) {
#pragma unroll
            for (int ks = 0; ks < 2; ++ks) { const bf16x8 bk = *(const LAS bf16x8*)(Kb + (16 * tj + r) * 72 + 32 * ks + 8 * q);
                kk = __builtin_amdgcn_mfma_f32_16x16x32_bf16(*(const LAS bf16x8*)(KBb + (16 * ti + r) * 72 + 32 * ks + 8 * q), bk, kk, 0, 0, 0);
                qk = __builtin_amdgcn_mfma_f32_16x16x32_bf16(*(const LAS bf16x8*)(Qb + (16 * ti + r) * 72 + 32 * ks + 8 * q), bk, qk, 0, 0, 0); } }
        const int cj = 16 * tj + r; const float gj = gcs[cj];
#pragma unroll
        for (int e = 0; e < 4; ++e) { const int ri = 16 * ti + 4 * q + e; const float dec = __expf(fminf(gcs[ri] - gj, 0.f));
            Lm[ri * 64 + cj] = (cj < ri) ? kk[e] * dec : 0.f;
            CO[DN_AQ + ri * 64 + pcol(cj)] = (bf16)f2bf((cj <= ri) ? qk[e] * dec : 0.f); } }
    __syncthreads();
    if (tid < 128) { float x[64];
#pragma unroll
        for (int i = 0; i < 64; ++i) { float a0 = RH[i * 128 + tid], a1 = 0.f, a2 = 0.f, a3 = 0.f;
#pragma unroll
            for (int j4 = 0; j4 < (i + 3) / 4; ++j4) { const f32x4 lv = *(const LAS f32x4*)(Lm + i * 64 + 4 * j4);
                if (4 * j4 < i) a0 -= lv[0] * x[4 * j4]; if (4 * j4 + 1 < i) a1 -= lv[1] * x[4 * j4 + 1]; if (4 * j4 + 2 < i) a2 -= lv[2] * x[4 * j4 + 2]; if (4 * j4 + 3 < i) a3 -= lv[3] * x[4 * j4 + 3]; }
            x[i] = (a0 + a1) + (a2 + a3); }
        if (tid < 64) { const int pc = pcol(tid);
#pragma unroll
            for (int i = 0; i < 64; ++i) CO[DN_NW + i * 64 + pc] = (bf16)f2bf(-x[i]); }
        else { bf16* ut = CO + DN_UT + (tid - 64) * 64;
#pragma unroll
            for (int i8 = 0; i8 < 8; ++i8) { u32x4 w; w.x = pk2(x[8 * i8], x[8 * i8 + 1]); w.y = pk2(x[8 * i8 + 2], x[8 * i8 + 3]); w.z = pk2(x[8 * i8 + 4], x[8 * i8 + 5]); w.w = pk2(x[8 * i8 + 6], x[8 * i8 + 7]); *(u32x4*)(ut + 8 * i8) = w; } } }
    __syncthreads();
}
__device__ __forceinline__ bf16x8 pack8(const f32x4& a, const f32x4& b) { u32x4 w; w.x = cvtpk(a[0], a[1]); w.y = cvtpk(a[2], a[3]); w.z = cvtpk(b[0], b[1]); w.w = cvtpk(b[2], b[3]); return __builtin_bit_cast(bf16x8, w); }
__device__ __forceinline__ void dn_item(Frame& F, int l, int b, int h) {
    const int lane = F.lane, r = lane & 15, q = lane >> 4;
    f32x4 S[4][4];
#pragma unroll
    for (int t = 0; t < 4; ++t)
#pragma unroll
        for (int d = 0; d < 4; ++d) S[t][d] = (f32x4){0.f, 0.f, 0.f, 0.f};
    float onorm[4];
#pragma unroll
    for (int d = 0; d < 4; ++d) onorm[d] = inp(F, 25)[l * 64 + 16 * d + r];
    for (int n = 0; n < 32; ++n) { const int c = (b * 4 + h) * 32 + n; const bf16* C = DNC_(F) + (size_t)c * DN_CH; const float dg = DG_(F)[c]; const size_t t0 = (size_t)b * SEQ + 64 * n;
        bf16x8 Sb[2][4], vnb[2][4];
#pragma unroll
        for (int s = 0; s < 2; ++s)
#pragma unroll
            for (int d = 0; d < 4; ++d) Sb[s][d] = pack8(S[2 * s][d], S[2 * s + 1][d]);
#pragma unroll
        for (int s2 = 0; s2 < 2; ++s2) { f32x4 vn[2][4];
#pragma unroll
            for (int mm = 0; mm < 2; ++mm) { const int m = 2 * s2 + mm; const bf16x8 a0 = *(const bf16x8*)(C + DN_NW + (16 * m + r) * 64 + 8 * q), a1 = *(const bf16x8*)(C + DN_NW + (16 * m + r) * 64 + 32 + 8 * q);
#pragma unroll
                for (int d = 0; d < 4; ++d) { const u32x2 uu = *(const u32x2*)(C + DN_UT + (16 * d + r) * 64 + 16 * m + 4 * q); f32x4 u = {bf_lo(uu.x), bf_hi(uu.x), bf_lo(uu.y), bf_hi(uu.y)};
                    u = __builtin_amdgcn_mfma_f32_16x16x32_bf16(a0, Sb[0][d], u, 0, 0, 0); vn[mm][d] = __builtin_amdgcn_mfma_f32_16x16x32_bf16(a1, Sb[1][d], u, 0, 0, 0); } }
#pragma unroll
            for (int d = 0; d < 4; ++d) vnb[s2][d] = pack8(vn[0][d], vn[1][d]); }
#pragma unroll
        for (int m = 0; m < 4; ++m) { const bf16x8 q0 = *(const bf16x8*)(C + DN_QD + (16 * m + r) * 64 + 8 * q), q1 = *(const bf16x8*)(C + DN_QD + (16 * m + r) * 64 + 32 + 8 * q);
            const bf16x8 k0 = *(const bf16x8*)(C + DN_AQ + (16 * m + r) * 64 + 8 * q), k1 = *(const bf16x8*)(C + DN_AQ + (16 * m + r) * 64 + 32 + 8 * q);
            f32x4 o[4]; float ss[4] = {0.f, 0.f, 0.f, 0.f};
#pragma unroll
            for (int d = 0; d < 4; ++d) { f32x4 a = {0.f, 0.f, 0.f, 0.f};
                a = __builtin_amdgcn_mfma_f32_16x16x32_bf16(q0, Sb[0][d], a, 0, 0, 0); a = __builtin_amdgcn_mfma_f32_16x16x32_bf16(q1, Sb[1][d], a, 0, 0, 0);
                a = __builtin_amdgcn_mfma_f32_16x16x32_bf16(k0, vnb[0][d], a, 0, 0, 0); if (m >= 2) a = __builtin_amdgcn_mfma_f32_16x16x32_bf16(k1, vnb[1][d], a, 0, 0, 0);
                o[d] = a;
#pragma unroll
                for (int i = 0; i < 4; ++i) ss[i] += a[i] * a[i]; }
#pragma unroll
            for (int i = 0; i < 4; ++i) { float v = ss[i]; v += __shfl_xor(v, 1); v += __shfl_xor(v, 2); v += __shfl_xor(v, 4); v += __shfl_xor(v, 8); ss[i] = 1.0f / sqrtf(v * (1.0f / 64.0f) + EPS); }
#pragma unroll
            for (int i = 0; i < 4; ++i) { bf16* gp = PROJ_(F) + (t0 + 16 * m + 4 * q + i) * PP + C_GATE + h * 64 + r;
#pragma unroll
                for (int d = 0; d < 4; ++d) { const float gt = bf2f(gp[16 * d]); gp[16 * d] = (bf16)f2bf(o[d][i] * ss[i] * onorm[d] * silu_f(gt)); } } }
#pragma unroll
        for (int t = 0; t < 4; ++t) { const bf16x8 a0 = *(const bf16x8*)(C + DN_KT + (16 * t + r) * 64 + 8 * q), a1 = *(const bf16x8*)(C + DN_KT + (16 * t + r) * 64 + 32 + 8 * q);
#pragma unroll
            for (int d = 0; d < 4; ++d) { f32x4 a = S[t][d] * dg; a = __builtin_amdgcn_mfma_f32_16x16x32_bf16(a0, vnb[0][d], a, 0, 0, 0); S[t][d] = __builtin_amdgcn_mfma_f32_16x16x32_bf16(a1, vnb[1][d], a, 0, 0, 0); } }
    }
}
constexpr int N_DN = 32, N_S5 = 128, N_ATT = 4096, N_ITEMS = N_DN + N_S5 + 2 * N_ATT;
__device__ __forceinline__ void mixer_phase(Frame& F, int l) {
    LAS unsigned char* scr = F.lds + F.wave * WSCR; LAS float* tbl = (LAS float*)(F.lds + TBL_OFF);
    for (int e = F.tid; e < 3 * 129 * 4; e += NWAVES * 64) tbl[e] = BIAS_(F)[e];
    __syncthreads();
    gu32* head = CTL_(F) + CW_Q + 64 * l;
    for (;;) {
        int idx = 0; if (F.lane == 0) idx = (int)__hip_atomic_fetch_add(head, 1u, RLX_AGENT);
        idx = __builtin_amdgcn_readfirstlane(idx);
        if (idx >= N_ITEMS) break;
        if (idx < N_DN) { if (PH_MASK & 256) dn_item(F, l, idx >> 2, idx & 3); continue; }
        idx -= N_DN;
        if (idx < N_S5) { if (PH_MASK & 512) s5_item(F, l, idx >> 4, idx & 15, scr); continue; }
        idx -= N_S5;
        const int j = idx >> 1;
        if ((idx & 1) == 0) { const int bh = j & 31, qt = 127 - (j >> 5); if (PH_MASK & 1024) mla_item(F, bh >> 2, bh & 3, qt, scr); }
        else { const int bh = j & 31, rest = j >> 5; if (PH_MASK & 2048) dil_item(F, bh >> 2, bh & 3, 7 - (rest >> 4), rest & 15, scr, tbl); }
    }
}

constexpr int N_PHASES = 1 + 7 * NL;
struct Args { const float* in[30]; float* out; unsigned char* ws; int ph_lo, ph_hi; };
__global__ void __launch_bounds__(NWAVES * 64, 2) fwd_megakernel(Args args) {
    extern __shared__ __attribute__((aligned(16))) unsigned char lds[];
    Frame F;
    F.lds = (LAS unsigned char*)lds;
    F.tid = threadIdx.x; F.lane = F.tid & 63; F.wave = __builtin_amdgcn_readfirstlane(F.tid >> 6);
    F.G = gridDim.x; { const int bx = blockIdx.x; F.vcu = (F.G % 8 == 0) ? (bx % 8) * (F.G / 8) + bx / 8 : bx; }
    F.out = args.out; F.ws = args.ws;
    if (F.tid < 30) { const unsigned long long p = (unsigned long long)args.in[F.tid]; ((LAS unsigned*)(F.lds + INP_OFF))[2 * F.tid] = (unsigned)p; ((LAS unsigned*)(F.lds + INP_OFF))[2 * F.tid + 1] = (unsigned)(p >> 32); }
    volatile LAS unsigned* MISC = (volatile LAS unsigned*)(F.lds + MISC_OFF);
    if (F.tid < 64) MISC[F.tid] = 0u;
    __syncthreads();
#if MK_MODE == 1
    cooperative_groups::grid_group grid = cooperative_groups::this_grid();
#define GRID_BAR() grid.sync()
#elif MK_MODE == 2
    XcdBarrier bar = xcd_barrier_post((unsigned*)(CTL_(F) + CW_BAR), MISC + 8);
#define GRID_BAR() xcd_barrier(bar)
#else
#define GRID_BAR() do {} while (0)
#endif
    const int lo = args.ph_lo, hi = args.ph_hi;
#define IN(p) (lo <= (p) && (p) < hi)
#define REFRESH() do { int tv = threadIdx.x; asm volatile("" : "+v"(tv)); F.tid = tv; F.lane = tv & 63; F.wave = __builtin_amdgcn_readfirstlane(tv >> 6); \
        unsigned long long wv = (unsigned long long)args.ws, ov = (unsigned long long)args.out; asm volatile("" : "+s"(wv), "+s"(ov)); F.ws = (unsigned char*)wv; F.out = (float*)ov; } while (0)
#define SEAM(p) do { if (IN(p) && IN((p) + 1)) GRID_BAR(); } while (0)
    if (IN(0)) { REFRESH(); if (PH_MASK & 1) p0_prologue(F); }
    SEAM(0);
#define LAYER(l) do { \
    if (IN(1 + 7 * (l)) && (PH_MASK & 2)) { REFRESH(); unsigned char* L = lw(F, l); \
        pg8::Gemm g{XB_(F), (const bf16*)(L + LW_WIN), TOK, PP, DM, DM}; pg8::StaticOrder S; S.init(TOK, PP, F.G, (int)blockIdx.x); \
        pg8::EpiRowScale E{PROJ_(F), PP, SSQ_(F) + (size_t)(2 * (l)) * TOK * 16}; \
        pg8::gemm_phase<pg8::EpiRowScale, pg8::StaticOrder, true, true>(F.lds, g, S, E); } \
    SEAM(1 + 7 * (l)); \
    if (IN(2 + 7 * (l)) && (PH_MASK & 4)) { REFRESH(); const int gw = F.vcu * NWAVES + F.wave, NGW = F.G * NWAVES; for (int t = gw; t < TOK; t += NGW) prep_token(F, l, t); \
        __syncthreads(); for (int c = (int)blockIdx.x; c < 1024; c += F.G) dn_chunk_prep(F, l, c); } \
    SEAM(2 + 7 * (l)); \
    if (IN(3 + 7 * (l)) && (PH_MASK & 8)) { REFRESH(); mixer_phase(F, l); } \
    SEAM(3 + 7 * (l)); \
    if (IN(4 + 7 * (l)) && (PH_MASK & 16)) { REFRESH(); unsigned char* L = lw(F, l); \
        pg8::Gemm g{YS5_(F), (const bf16*)(L + LW_WGLU), TOK, 512, 256, 256}; pg8::StaticOrder S; S.init(TOK, 512, F.G, (int)blockIdx.x); \
        pg8::EpiGated<1> E{PROJ_(F) + C_US5, PP, nullptr}; \
        pg8::gemm_phase<pg8::EpiGated<1>, pg8::StaticOrder, true, true>(F.lds, g, S, E); } \
    SEAM(4 + 7 * (l)); \
    if (IN(5 + 7 * (l)) && (PH_MASK & 32)) { REFRESH(); unsigned char* L = lw(F, l); \
        pg8::Gemm g{PROJ_(F), (const bf16*)(L + LW_WOUT), TOK, DM, DM, PP}; pg8::StaticOrder S; S.init(TOK, DM, F.G, (int)blockIdx.x); \
        pg8::EpiResid E{(l) == 0 ? inp(F, 0) : F.out, F.out, XB_(F), SSQ_(F) + (size_t)(2 * (l) + 1) * TOK * 16}; \
        pg8::gemm_phase<pg8::EpiResid, pg8::StaticOrder, true, true>(F.lds, g, S, E); } \
    SEAM(5 + 7 * (l)); \
    if (IN(6 + 7 * (l)) && (PH_MASK & 64)) { REFRESH(); unsigned char* L = lw(F, l); \
        pg8::Gemm g{XB_(F), (const bf16*)(L + LW_W13), TOK, 2 * FFH, DM, DM}; pg8::StaticOrder S; S.init(TOK, 2 * FFH, F.G, (int)blockIdx.x); \
        pg8::EpiGated<0> E{PROJ_(F), FFH, SSQ_(F) + (size_t)(2 * (l) + 1) * TOK * 16}; \
        pg8::gemm_phase<pg8::EpiGated<0>, pg8::StaticOrder, true, true>(F.lds, g, S, E); } \
    SEAM(6 + 7 * (l)); \
    if (IN(7 + 7 * (l)) && (PH_MASK & 128)) { REFRESH(); unsigned char* L = lw(F, l); \
        pg8::Gemm g{PROJ_(F), (const bf16*)(L + LW_W2), TOK, DM, FFH, FFH}; pg8::StaticOrder S; S.init(TOK, DM, F.G, (int)blockIdx.x); \
        pg8::EpiResid E{F.out, F.out, XB_(F), SSQ_(F) + (size_t)(2 * (l) + 2) * TOK * 16}; \
        pg8::gemm_phase<pg8::EpiResid, pg8::StaticOrder, true, true>(F.lds, g, S, E); } \
    SEAM(7 + 7 * (l)); } while (0)
    LAYER(0);
    LAYER(1);
}

extern "C" void kernel_launch(void* const* d_in, const int* in_sizes, int n_in, void* d_out, int out_size, void* d_ws, size_t ws_size, hipStream_t stream) {
    static int grid = 0;
    if (grid == 0) {
        if (n_in != 30 || in_sizes[0] != TOK * DM || out_size != TOK * DM || ws_size < WS_END) {
            fprintf(stderr, "kernel_launch: unexpected shapes: n_in %d in0 %d out %d ws %zu (need %zu); nothing launched\n", n_in, n_in > 0 ? in_sizes[0] : -1, out_size, ws_size, (size_t)WS_END); grid = -1; return; }
        int dev = 0, cus = 0, per_cu = 0;
        if (hipGetDevice(&dev) != hipSuccess || hipDeviceGetAttribute(&cus, hipDeviceAttributeMultiprocessorCount, dev) != hipSuccess) { fprintf(stderr, "kernel_launch: device query failed\n"); grid = -1; return; }
        if (hipFuncSetAttribute((const void*)fwd_megakernel, hipFuncAttributeMaxDynamicSharedMemorySize, LDS_BYTES) != hipSuccess) { fprintf(stderr, "kernel_launch: hipFuncSetAttribute failed\n"); grid = -1; return; }
        if (hipOccupancyMaxActiveBlocksPerMultiprocessor(&per_cu, (const void*)fwd_megakernel, NWAVES * 64, LDS_BYTES) != hipSuccess || per_cu < 1) {
            fprintf(stderr, "kernel_launch: occupancy query reports %d workgroups per CU; nothing launched\n", per_cu); (void)hipGetLastError(); grid = -1; return; }
        grid = cus;
    }
    if (grid < 0) return;
    if (hipMemsetAsync((char*)d_ws + WS_CTL, 0, CTL_ZERO_BYTES, stream) != hipSuccess) { fprintf(stderr, "kernel_launch: memset failed\n"); return; }
    Args a{};
    for (int i = 0; i < 30; ++i) a.in[i] = (const float*)d_in[i];
    a.out = (float*)d_out; a.ws = (unsigned char*)d_ws;
#if MK_MODE == 0
    for (int p = 0; p < N_PHASES; ++p) { a.ph_lo = p; a.ph_hi = p + 1; hipLaunchKernelGGL(fwd_megakernel, dim3(grid), dim3(NWAVES * 64), LDS_BYTES, stream, a); }
#elif MK_MODE == 1
    a.ph_lo = 0; a.ph_hi = N_PHASES; void* kargs[] = {&a};
    hipError_t e = hipLaunchCooperativeKernel((const void*)fwd_megakernel, dim3(grid), dim3(NWAVES * 64), kargs, LDS_BYTES, stream);
    if (e != hipSuccess) fprintf(stderr, "kernel_launch: cooperative launch failed: %s (grid %d)\n", hipGetErrorString(e), grid);
#else
    a.ph_lo = 0; a.ph_hi = N_PHASES;
    hipLaunchKernelGGL(fwd_megakernel, dim3(grid), dim3(NWAVES * 64), LDS_BYTES, stream, a);
#endif
    const hipError_t le = hipPeekAtLastError();
    if (le != hipSuccess) fprintf(stderr, "kernel_launch: launch failed: %s\n", hipGetErrorName(le));
}
```

```cpp
#include <hip/hip_runtime.h>
#include <hip/hip_cooperative_groups.h>
#include <cstdio>
#include <cstdint>
#include <cmath>
#ifndef MK_MODE
#define MK_MODE 2
#endif
#ifndef PH_MASK
#define PH_MASK 0xFFFF
#endif
#ifndef REP_GEMM
#define REP_GEMM 1
#endif
#ifndef REP_S5
#define REP_S5 1
#endif
#ifndef REP_MLA
#define REP_MLA 1
#endif
#ifndef REP_PRO
#define REP_PRO 1
#endif
#ifndef REP_DNP
#define REP_DNP 1
#endif

namespace pg8 {
#define PG8_LAS __attribute__((address_space(3)))
typedef unsigned short bf16_t;
typedef short bf16x8 __attribute__((ext_vector_type(8)));
typedef float f32x4 __attribute__((ext_vector_type(4)));
typedef unsigned u32x4 __attribute__((ext_vector_type(4)));
constexpr int BM = 256, BK = 64, HALF = 128, HTB = HALF * BK * 2  , STAGE_BYTES = 8 * HTB, NXCD = 8, WGM = 8;

__host__ __device__ __forceinline__ int lds_byte(int r, int c) { const int st = (r >> 4) * 2 + (c >> 5), rr = r & 15, cc = c & 31, ob = rr * 64 + cc * 2; return st * 1024 + (ob ^ (((ob >> 9) & 1) << 5)); }
__host__ __device__ __forceinline__ void stage_rc(int b, int& R, int& C) { const int st = b / 1024, sb = b % 1024, swz = sb ^ (((sb >> 9) & 1) << 5); R = (st >> 1) * 16 + swz / 64; C = (st & 1) * 32 + (swz % 64) / 2; }
__host__ __device__ __forceinline__ int perm32(int rho) { const int n = rho >> 4, i = rho & 15; return 8 * (i >> 2) + 4 * n + (i & 3); }

struct Unit { int pm, pn; };
struct Gemm { const bf16_t* A; const bf16_t* Bt; int M, N, K, lda; };

struct StaticOrder {
    int nM, nN, nwg, G, c;
    __host__ __device__ void init(int M, int N, int G_, int c_) { nM = M / BM; nN = N / BM; nwg = nM * nN; G = G_; c = c_; }
    __host__ __device__ bool next(int i, Unit& u) const {
        const long L = (long)i * G + c; if (L >= nwg) return false;
        int wgid = (int)L; { const int q = nwg / NXCD, r = nwg % NXCD, xcd = wgid % NXCD, off = wgid / NXCD; wgid = (xcd < r ? xcd * (q + 1) : r * (q + 1) + (xcd - r) * q) + off; }
        const int nig = WGM * nN, gid = wgid / nig, fm = gid * WGM, gsz = (nM - fm) < WGM ? (nM - fm) : WGM;
        u.pm = fm + ((wgid % nig) % gsz); u.pn = (wgid % nig) / gsz; return true;
    }
    __device__ __forceinline__ void a_ready(const Unit&) const {}
    __device__ __forceinline__ void done(const Unit&) const {}
};

__device__ __forceinline__ unsigned cvt_pk_bf16(float lo, float hi) { unsigned r; asm volatile("v_cvt_pk_bf16_f32 %0, %1, %2" : "=v"(r) : "v"(lo), "v"(hi)); return r; }
__device__ __forceinline__ float row_rs(const float* ssq, int row) {
    const f32x4* p = (const f32x4*)(ssq + (size_t)row * 16); const f32x4 a = p[0], b = p[1], c = p[2], d = p[3];
    const float s = ((a[0] + a[1]) + (a[2] + a[3])) + ((b[0] + b[1]) + (b[2] + b[3])) + ((c[0] + c[1]) + (c[2] + c[3])) + ((d[0] + d[1]) + (d[2] + d[3]));
    return 1.0f / sqrtf(s * (1.0f / 1024.0f) + 1e-6f);
}
struct EpiRowScale {
    static constexpr bool PERM = true, AFTER_DRAIN = false;
    bf16_t* O; int ldc; const float* ssq;
    __device__ __forceinline__ void operator()(const f32x4 (&acc)[2][2][4][2], const Unit& u, int wr, int wc, int fr, int fq) const {
        const int row0 = u.pm * BM + wr * 64 + fr, col0 = u.pn * BM + wc * 32 + 8 * fq;
#pragma unroll
        for (int ai = 0; ai < 2; ++ai)
#pragma unroll
            for (int m = 0; m < 4; ++m) { const int row = row0 + ai * HALF + m * 16; const float rs = row_rs(ssq, row); bf16_t* rowp = O + (size_t)row * ldc + col0;
#pragma unroll
                for (int bj = 0; bj < 2; ++bj) { const f32x4 v0 = acc[ai][bj][m][0] * rs, v1 = acc[ai][bj][m][1] * rs;
                    u32x4 w; w.x = cvt_pk_bf16(v0[0], v0[1]); w.y = cvt_pk_bf16(v0[2], v0[3]); w.z = cvt_pk_bf16(v1[0], v1[1]); w.w = cvt_pk_bf16(v1[2], v1[3]);
                    *(u32x4*)(rowp + bj * HALF) = w; } }
    }
};
template <int mode> struct EpiGated {
    static constexpr bool PERM = true, AFTER_DRAIN = false;
    bf16_t* O; int ldc; const float* ssq;
    __device__ __forceinline__ void operator()(const f32x4 (&acc)[2][2][4][2], const Unit& u, int wr, int wc, int fr, int fq) const {
        const int row0 = u.pm * BM + wr * 64 + fr, col0 = u.pn * HALF + wc * 32 + 8 * fq;
#pragma unroll
        for (int ai = 0; ai < 2; ++ai)
#pragma unroll
            for (int m = 0; m < 4; ++m) { const int row = row0 + ai * HALF + m * 16; const float rs = (mode == 0) ? row_rs(ssq, row) : 1.0f;
                float o[8];
#pragma unroll
                for (int n = 0; n < 2; ++n)
#pragma unroll
                    for (int j = 0; j < 4; ++j) { const float a = acc[ai][0][m][n][j] * rs, b = acc[ai][1][m][n][j] * rs;
                        const float x = (mode == 0) ? a : b; const float sg = 1.0f / (1.0f + __expf(-x));
                        o[n * 4 + j] = (mode == 0) ? (a * sg) * b : a * sg; }
                u32x4 w; w.x = cvt_pk_bf16(o[0], o[1]); w.y = cvt_pk_bf16(o[2], o[3]); w.z = cvt_pk_bf16(o[4], o[5]); w.w = cvt_pk_bf16(o[6], o[7]);
                *(u32x4*)(O + (size_t)row * ldc + col0) = w; }
    }
};
struct EpiResid {
    static constexpr bool PERM = true, AFTER_DRAIN = false;
    const float* hin; float* hout; bf16_t* xb; float* ssq; int dry;
    __device__ __forceinline__ void operator()(const f32x4 (&acc)[2][2][4][2], const Unit& u, int wr, int wc, int fr, int fq) const {
        const int row0 = u.pm * BM + wr * 64 + fr, col0 = u.pn * BM + wc * 32 + 8 * fq;
#pragma unroll
        for (int ai = 0; ai < 2; ++ai)
#pragma unroll
            for (int m = 0; m < 4; ++m) { const int row = row0 + ai * HALF + m * 16; const size_t off = (size_t)row * 1024 + col0; float sq = 0.f;
#pragma unroll
                for (int bj = 0; bj < 2; ++bj) {
                    const f32x4 h0 = *(const f32x4*)(hin + off + bj * HALF) + acc[ai][bj][m][0], h1 = *(const f32x4*)(hin + off + bj * HALF + 4) + acc[ai][bj][m][1];
                    if (!dry) { *(f32x4*)(hout + off + bj * HALF) = h0; *(f32x4*)(hout + off + bj * HALF + 4) = h1; }
                    u32x4 w; w.x = cvt_pk_bf16(h0[0], h0[1]); w.y = cvt_pk_bf16(h0[2], h0[3]); w.z = cvt_pk_bf16(h1[0], h1[1]); w.w = cvt_pk_bf16(h1[2], h1[3]);
                    *(u32x4*)(xb + off + bj * HALF) = w;
                    sq += (h0[0] * h0[0] + h0[1] * h0[1]) + (h0[2] * h0[2] + h0[3] * h0[3]) + (h1[0] * h1[0] + h1[1] * h1[1]) + (h1[2] * h1[2] + h1[3] * h1[3]); }
                sq += __shfl_xor(sq, 16); sq += __shfl_xor(sq, 32);
                if (fq == 0) ssq[(size_t)row * 16 + u.pn * 4 + wc] = sq; }
    }
};

template <class Epi, class Sched, bool ALIGN_EPI = false, bool SP2 = false>
__device__ __forceinline__ void gemm_phase(PG8_LAS unsigned char* lds, const Gemm g, const Sched& S, const Epi& E) {
    int tid_ = threadIdx.x; asm volatile("" : "+v"(tid_)); const int tid = tid_, wid = __builtin_amdgcn_readfirstlane(tid >> 6), lane = tid & 63, wr = wid >> 2, wc = wid & 3, fr = lane & 15, fq = lane >> 4;
    int K_ = g.K; asm volatile("" : "+s"(K_)); const int K = K_, nt = K / BK;
    unsigned voffA[2], voffB[2];
#pragma unroll
    for (int i = 0; i < 2; ++i) { int R, C; stage_rc(tid * 16 + i * 8192, R, C); const int Rb = Epi::PERM ? ((R & ~31) + perm32(R & 31)) : R;
        voffA[i] = (unsigned)(R * g.lda + C) * 2u; voffB[i] = (unsigned)(Rb * K + C) * 2u; }
    const size_t kstep = (size_t)(BK * 2);
    const size_t hstepB = (size_t)HALF * K * 2, hstepA = (size_t)HALF * g.lda * 2;
    const size_t tstepB = 2 * hstepB, tstepA = 2 * hstepA;
    const unsigned ldsw = (unsigned)wid * 1024u;
    const int aoff = lds_byte(wr * 64 + fr, fq * 8), boff = lds_byte(wc * 32 + fr, fq * 8);
#define PG8_SA(b, h) (((b) * 2 + (h)) * HTB)
#define PG8_SB(b, h) ((4 + (b) * 2 + (h)) * HTB)
#define PG8_STAGE(bufoff, gbase, voff) do { _Pragma("unroll") for (int _i = 0; _i < 2; ++_i) \
        __builtin_amdgcn_global_load_lds((const unsigned*)((const char*)(gbase) + (voff)[_i]), (PG8_LAS unsigned*)(lds + (bufoff) + ldsw + _i * 8192), 16, 0, 0); } while (0)
#define PG8_LDA(dst, b, h) do { _Pragma("unroll") for (int m = 0; m < 4; ++m) _Pragma("unroll") for (int k = 0; k < 2; ++k) dst[m][k] = *(const PG8_LAS bf16x8*)(lds + PG8_SA(b, h) + aoff + m * 2048 + k * 1024); } while (0)
#define PG8_LDB(dst, b, h) do { _Pragma("unroll") for (int n = 0; n < 2; ++n) _Pragma("unroll") for (int k = 0; k < 2; ++k) dst[n][k] = *(const PG8_LAS bf16x8*)(lds + PG8_SB(b, h) + boff + n * 2048 + k * 1024); } while (0)
#define PG8_MMA(ai, bj, At, Bt) do { __builtin_amdgcn_s_setprio(1); _Pragma("unroll") for (int m = 0; m < 4; ++m) _Pragma("unroll") for (int n = 0; n < 2; ++n) _Pragma("unroll") for (int k = 0; k < 2; ++k) \
        acc[ai][bj][m][n] = __builtin_amdgcn_mfma_f32_16x16x32_bf16(Bt[n][k], At[m][k], acc[ai][bj][m][n], 0, 0, 0); __builtin_amdgcn_s_setprio(0); } while (0)
#define PG8_WAIT_V(n) asm volatile("s_waitcnt vmcnt(" #n ")" ::: "memory")
#define PG8_WAIT_L(n) asm volatile("s_waitcnt lgkmcnt(" #n ")" ::: "memory")
#define PG8_BAR __builtin_amdgcn_s_barrier()
#define PG8_SCHED __builtin_amdgcn_sched_barrier(0)
    Unit cur, nxt; int ui = 0;
    if (!S.next(0, cur)) return;
    f32x4 acc[2][2][4][2];
#pragma unroll
    for (int a = 0; a < 2; ++a)
#pragma unroll
        for (int b = 0; b < 2; ++b)
#pragma unroll
            for (int m = 0; m < 4; ++m)
#pragma unroll
                for (int n = 0; n < 2; ++n) acc[a][b][m][n] = (f32x4){0.f, 0.f, 0.f, 0.f};
    bf16x8 At[4][2], B0[2][2], B1[2][2];
    const char* cA = (const char*)g.A + (size_t)cur.pm * tstepA; const char* cB = (const char*)g.Bt + (size_t)cur.pn * tstepB;
    S.a_ready(cur);
    if constexpr (SP2) {
        PG8_STAGE(PG8_SB(0, 0), cB, voffB); PG8_STAGE(PG8_SB(0, 1), cB + hstepB, voffB); PG8_STAGE(PG8_SA(0, 0), cA, voffA); PG8_STAGE(PG8_SA(0, 1), cA + hstepA, voffA);
        if (wr == 1) PG8_BAR;
        PG8_WAIT_V(2); PG8_BAR;
        PG8_STAGE(PG8_SB(1, 0), cB + kstep, voffB); PG8_STAGE(PG8_SA(1, 0), cA + kstep, voffA); PG8_STAGE(PG8_SB(1, 1), cB + hstepB + kstep, voffB);
        PG8_WAIT_V(6); PG8_BAR;
    } else {
        PG8_STAGE(PG8_SB(0, 0), cB, voffB); PG8_STAGE(PG8_SA(0, 0), cA, voffA); PG8_STAGE(PG8_SB(0, 1), cB + hstepB, voffB); PG8_STAGE(PG8_SA(0, 1), cA + hstepA, voffA);
        if (wr == 1) PG8_BAR;
        PG8_WAIT_V(4); PG8_BAR;
        PG8_STAGE(PG8_SB(1, 0), cB + kstep, voffB); PG8_STAGE(PG8_SA(1, 0), cA + kstep, voffA); PG8_STAGE(PG8_SB(1, 1), cB + hstepB + kstep, voffB);
        PG8_WAIT_V(6); PG8_BAR;
    }
    for (;;) {
        const bool has_next = S.next(ui + 1, nxt);
        const char* nA = has_next ? (const char*)g.A + (size_t)nxt.pm * tstepA : cA; const char* nB = has_next ? (const char*)g.Bt + (size_t)nxt.pn * tstepB : cB;
        for (int t = 0; t < nt; t += 2) {
            const bool last = (t == nt - 2);
            const char* a1 = cA + (size_t)(t + 1) * kstep;
            const char* a2 = last ? nA : cA + (size_t)(t + 2) * kstep; const char* b2 = last ? nB : cB + (size_t)(t + 2) * kstep;
            const char* a3 = a2 + kstep; const char* b3 = b2 + kstep;
            if (last && has_next) S.a_ready(nxt);
            if constexpr (SP2) {
            PG8_LDB(B0, 0, 0); PG8_LDB(B1, 0, 1); PG8_SCHED; PG8_LDA(At, 0, 0); PG8_STAGE(PG8_SA(1, 1), a1 + hstepA, voffA);
            PG8_WAIT_V(8); PG8_WAIT_L(0); PG8_BAR; PG8_MMA(0, 0, At, B0); PG8_MMA(0, 1, At, B1); PG8_BAR; PG8_SCHED;
            PG8_LDA(At, 0, 1); PG8_STAGE(PG8_SB(0, 0), b2, voffB); PG8_STAGE(PG8_SB(0, 1), b2 + hstepB, voffB); PG8_STAGE(PG8_SA(0, 0), a2, voffA);
            PG8_WAIT_V(8); PG8_WAIT_L(0); PG8_BAR; PG8_MMA(1, 0, At, B0); PG8_MMA(1, 1, At, B1); PG8_BAR; PG8_SCHED;
            PG8_LDB(B0, 1, 0); PG8_LDB(B1, 1, 1); PG8_SCHED; PG8_LDA(At, 1, 0); PG8_STAGE(PG8_SA(0, 1), a2 + hstepA, voffA);
            PG8_WAIT_V(8); PG8_WAIT_L(0); PG8_BAR; PG8_MMA(0, 0, At, B0); PG8_MMA(0, 1, At, B1); PG8_BAR; PG8_SCHED;
            PG8_LDA(At, 1, 1); PG8_STAGE(PG8_SB(1, 0), b3, voffB); PG8_STAGE(PG8_SB(1, 1), b3 + hstepB, voffB); PG8_STAGE(PG8_SA(1, 0), a3, voffA);
            PG8_WAIT_V(8); PG8_WAIT_L(0); PG8_BAR; PG8_MMA(1, 0, At, B0); PG8_MMA(1, 1, At, B1); PG8_BAR; PG8_SCHED;
            } else {
            PG8_LDB(B0, 0, 0); PG8_SCHED; PG8_LDA(At, 0, 0); PG8_STAGE(PG8_SA(1, 1), a1 + hstepA, voffA);
            PG8_WAIT_L(8); PG8_BAR; PG8_WAIT_L(0); PG8_MMA(0, 0, At, B0); PG8_BAR; PG8_SCHED;
            PG8_LDB(B1, 0, 1); PG8_STAGE(PG8_SB(0, 0), b2, voffB);
            PG8_BAR; PG8_WAIT_L(0); PG8_MMA(0, 1, At, B1); PG8_BAR;
            PG8_LDA(At, 0, 1); PG8_STAGE(PG8_SA(0, 0), a2, voffA);
            PG8_BAR; PG8_WAIT_L(0); PG8_MMA(1, 0, At, B0); PG8_BAR; PG8_SCHED;
            PG8_STAGE(PG8_SB(0, 1), b2 + hstepB, voffB);
            PG8_WAIT_V(6); PG8_BAR; PG8_MMA(1, 1, At, B1); PG8_BAR;
            PG8_LDB(B0, 1, 0); PG8_SCHED; PG8_LDA(At, 1, 0); PG8_STAGE(PG8_SA(0, 1), a2 + hstepA, voffA);
            PG8_WAIT_L(8); PG8_BAR; PG8_WAIT_L(0); PG8_MMA(0, 0, At, B0); PG8_BAR; PG8_SCHED;
            PG8_LDB(B1, 1, 1); PG8_STAGE(PG8_SB(1, 0), b3, voffB);
            PG8_BAR; PG8_WAIT_L(0); PG8_MMA(0, 1, At, B1); PG8_BAR;
            PG8_LDA(At, 1, 1); PG8_STAGE(PG8_SA(1, 0), a3, voffA);
            PG8_BAR; PG8_WAIT_L(0); PG8_MMA(1, 0, At, B0); PG8_BAR; PG8_SCHED;
            PG8_STAGE(PG8_SB(1, 1), b3 + hstepB, voffB);
            PG8_WAIT_V(6); PG8_BAR; PG8_MMA(1, 1, At, B1); PG8_BAR;
            }
        }
        if constexpr (ALIGN_EPI) { if (wr == 0) PG8_BAR; }
        if constexpr (!Epi::AFTER_DRAIN) { E(acc, cur, wr, wc, fr, fq); S.done(cur); }
        if (!has_next) break;
#pragma unroll
        for (int a = 0; a < 2; ++a)
#pragma unroll
            for (int b = 0; b < 2; ++b)
#pragma unroll
                for (int m = 0; m < 4; ++m)
#pragma unroll
                    for (int n = 0; n < 2; ++n) acc[a][b][m][n] = (f32x4){0.f, 0.f, 0.f, 0.f};
        cur = nxt; cA = nA; cB = nB; ++ui;
        if constexpr (ALIGN_EPI) { if (wr == 1) PG8_BAR; }
    }
    PG8_WAIT_V(0);
    if constexpr (!ALIGN_EPI) { if (wr == 0) PG8_BAR; }
    PG8_BAR;
    if constexpr (Epi::AFTER_DRAIN) { E.fused(acc, cur, wr, wc, fr, fq, lds, wid, lane); S.done(cur); }
#undef PG8_SA
#undef PG8_SB
#undef PG8_STAGE
#undef PG8_LDA
#undef PG8_LDB
#undef PG8_MMA
#undef PG8_WAIT_V
#undef PG8_WAIT_L
#undef PG8_BAR
#undef PG8_SCHED
}
}


constexpr int NWAVES = 8;
constexpr int NB = 8, SEQ = 2048, TOK = NB * SEQ, DM = 1024, NL = 2;
constexpr int INC = 2472;
constexpr int PP = 3584;
constexpr int FFH = 2816;
constexpr float EPS = 1e-6f;
constexpr float LOG2E = 1.4426950408889634f;
constexpr int C_CQ = 0;
constexpr int C_US5 = 256;
constexpr int C_DQ = 512;
constexpr int C_GATE = 768;
constexpr int C_DK = 1024, C_DV = 1280;
constexpr int C_MQ = 1536;
constexpr int C_MKV = 1920;
constexpr int C_CKV = 2432;
constexpr int C_DN = 2560;
constexpr int C_KR = 3328;
constexpr int C_A = 3360, C_B = 3364;

constexpr size_t WS_CTL = 0, CTL_ZERO_BYTES = 1u << 20;
constexpr size_t SZ_WIN = (size_t)PP * DM * 2, SZ_WOUT = (size_t)DM * DM * 2, SZ_W13 = (size_t)2 * FFH * DM * 2, SZ_W2 = (size_t)DM * FFH * 2, SZ_WGLU = (size_t)512 * 256 * 2;
constexpr size_t SZ_AB = 16 * 64 * 2 * 4, SZ_BB = 16 * 64 * 16 * 2 * 4;
constexpr size_t LW_WIN = 0, LW_WOUT = LW_WIN + SZ_WIN, LW_W13 = LW_WOUT + SZ_WOUT, LW_W2 = LW_W13 + SZ_W13, LW_WGLU = LW_W2 + SZ_W2, LW_AB = LW_WGLU + SZ_WGLU, LW_BB = LW_AB + SZ_AB, LW_SIZE = LW_BB + SZ_BB;
constexpr size_t WS_LW = 1u << 20;
constexpr size_t WS_BIAS = WS_LW + NL * LW_SIZE;
constexpr size_t WS_XB = WS_BIAS + 8192;
constexpr size_t WS_SSQ = WS_XB + (size_t)TOK * DM * 2;
constexpr size_t SZ_SSQ = (size_t)TOK * 16 * 4;
constexpr size_t WS_PROJ = WS_SSQ + 5 * SZ_SSQ;
constexpr size_t WS_DNC = WS_PROJ + (size_t)TOK * PP * 2;
constexpr size_t WS_DG = WS_DNC + (size_t)1024 * 20480 * 2;
constexpr size_t WS_YS5 = WS_DG + 4096;
constexpr size_t WS_END = WS_YS5 + (size_t)TOK * 256 * 2;
static_assert(WS_END <= 268435456ull, "d_ws map must fit 256 MiB");
static_assert(WS_LW % 256 == 0 && LW_SIZE % 256 == 0 && WS_XB % 256 == 0 && WS_PROJ % 256 == 0, "alignment");
constexpr int CW_TMO = 0;
constexpr int CW_Q = 512;
constexpr int CW_BAR = 4096;

constexpr int WSCR = 18432;
constexpr int SCR_BYTES = NWAVES * WSCR;
constexpr int TBL_OFF = SCR_BYTES;
constexpr int MISC_OFF = TBL_OFF + 6400;
constexpr int INP_OFF = MISC_OFF + 256;
constexpr int LDS_BYTES = INP_OFF + 256;
static_assert(LDS_BYTES <= 160 * 1024, "LDS");

#define GAS __attribute__((address_space(1)))
#define LAS __attribute__((address_space(3)))
typedef unsigned short bf16;
typedef float f32x4 __attribute__((ext_vector_type(4)));
typedef short bf16x8 __attribute__((ext_vector_type(8)));
typedef short s16x4 __attribute__((ext_vector_type(4)));
typedef unsigned u32x4 __attribute__((ext_vector_type(4)));
typedef unsigned u32x2 __attribute__((ext_vector_type(2)));
typedef GAS unsigned gu32;
#define RLX_AGENT __ATOMIC_RELAXED, __HIP_MEMORY_SCOPE_AGENT
#define WAVE_FENCE() do { asm volatile("" ::: "memory"); __builtin_amdgcn_wave_barrier(); asm volatile("" ::: "memory"); } while (0)

__device__ __forceinline__ float bf_lo(unsigned u) { return __uint_as_float(u << 16); }
__device__ __forceinline__ float bf_hi(unsigned u) { return __uint_as_float(u & 0xffff0000u); }
__device__ __forceinline__ float bf2f(bf16 u) { return __uint_as_float((unsigned)u << 16); }
__device__ __forceinline__ unsigned f2bf(float f) { unsigned u = __builtin_bit_cast(unsigned, f); return (u + 0x7fffu + ((u >> 16) & 1u)) >> 16; }
__device__ __forceinline__ unsigned pk2(float lo, float hi) { return f2bf(lo) | (f2bf(hi) << 16); }
__device__ __forceinline__ float wave_sum(float v) {
#pragma unroll
    for (int o = 1; o < 64; o <<= 1) v += __shfl_xor(v, o);
    return v;
}
__device__ __forceinline__ float grp16_sum(float v) {
#pragma unroll
    for (int o = 1; o < 16; o <<= 1) v += __shfl_xor(v, o);
    return v;
}
__device__ __forceinline__ float silu_f(float x) { return x / (1.0f + __expf(-x)); }

#if MK_MODE == 2
#define XB_TMO      128
#define XB_XCNT(j)  (256  + 64 * (j))
#define XB_XSUB(j)  (1280 + 64 * (j))
#define XB_XGEN(j)  (2304 + 64 * (j))
#define XB_TOP      3328
#define XB_TOPGEN   3392
#define XCD_BAR_WORDS 3456
#define XB_SPIN_CAP (1u << 20)
__device__ __forceinline__ unsigned xb_ld(unsigned* p)              { return __hip_atomic_load(p, __ATOMIC_RELAXED, __HIP_MEMORY_SCOPE_AGENT); }
__device__ __forceinline__ unsigned xb_add(unsigned* p, unsigned v) { return __hip_atomic_fetch_add(p, v, __ATOMIC_RELAXED, __HIP_MEMORY_SCOPE_AGENT); }
__device__ __forceinline__ unsigned xb_xcc_id() { return (unsigned)__builtin_amdgcn_s_getreg((3 << 11) | 20) & 0xFu; }
#define XB_SPIN(cond, bar) do { unsigned _sp = 0; while (cond) { __builtin_amdgcn_s_sleep(1); \
    if ((++_sp & 255u) == 0u) { if (xb_ld(&(bar)[XB_TMO])) break; if (_sp > XB_SPIN_CAP) { atomicAdd(&(bar)[XB_TMO], 1u); break; } } } } while (0)
struct XcdBarrier { unsigned* bar; unsigned x; volatile LAS unsigned* st; };
__device__ __forceinline__ XcdBarrier xcd_barrier_post(unsigned* bar, volatile LAS unsigned* st) {
    XcdBarrier b; b.bar = bar; b.x = xb_xcc_id(); b.st = st;
    if (threadIdx.x == 0) (void)xb_add(&bar[XB_XCNT(b.x)], 1u);
    return b;
}
__device__ __forceinline__ void xcd_barrier_complete(unsigned* bar, unsigned x, unsigned& nloc, unsigned& nx) {
    const unsigned G = gridDim.x * gridDim.y * gridDim.z;
    unsigned sum, cnt, mine, sp = 0u;
    for (;;) {
        sum = 0u; cnt = 0u; mine = 0u;
#pragma unroll
        for (unsigned j = 0; j < 16; ++j) { const unsigned c = xb_ld(&bar[XB_XCNT(j)]); sum += c; cnt += (c > 0u) ? 1u : 0u; mine = (j == x) ? c : mine; }
        if (sum == G) break;
        __builtin_amdgcn_s_sleep(1);
        if ((++sp & 255u) == 0u) { if (xb_ld(&bar[XB_TMO])) break; if (sp > XB_SPIN_CAP) { atomicAdd(&bar[XB_TMO], 1u); break; } }
    }
    nloc = mine > 0u ? mine : 1u; nx = cnt > 0u ? cnt : 1u;
}
__device__ __forceinline__ void xcd_barrier(const XcdBarrier& b) {
    asm volatile("s_waitcnt vmcnt(0)" ::: "memory");
    __syncthreads();
    if (threadIdx.x == 0) {
        unsigned* bar = b.bar;
        __builtin_amdgcn_s_waitcnt(0);
        unsigned nloc = b.st[0], nx = b.st[1];
        if (nloc == 0u) { xcd_barrier_complete(bar, b.x, nloc, nx); b.st[0] = nloc; b.st[1] = nx; }
        const unsigned old = xb_add(&bar[XB_XSUB(b.x)], 1u);
        const unsigned gen = old / nloc;
        if (old + 1u == (gen + 1u) * nloc) {
            __builtin_amdgcn_fence(__ATOMIC_RELEASE, "agent");
            asm volatile("s_waitcnt vmcnt(0)" ::: "memory");
            const unsigned og = xb_add(&bar[XB_TOP], 1u);
            const unsigned tg = og / nx;
            if (og + 1u == (tg + 1u) * nx) xb_add(&bar[XB_TOPGEN], 1u);
            else XB_SPIN(xb_ld(&bar[XB_TOPGEN]) == tg, bar);
            __builtin_amdgcn_fence(__ATOMIC_ACQUIRE, "agent");
            xb_add(&bar[XB_XGEN(b.x)], 1u);
            asm volatile("s_waitcnt vmcnt(0)" ::: "memory");
        } else {
            XB_SPIN(xb_ld(&bar[XB_XGEN(b.x)]) == gen, bar);
            __builtin_amdgcn_fence(__ATOMIC_ACQUIRE, "agent");
            asm volatile("s_waitcnt vmcnt(0)" ::: "memory");
        }
    }
    __syncthreads();
}
#endif

struct Frame {
    LAS unsigned char* lds;
    unsigned char* ws;
    float* out;
    int tid, lane, wave, vcu, G;
};
__device__ __forceinline__ const float* inp(const Frame& F, int i) {
    const LAS unsigned* t = (const LAS unsigned*)(F.lds + INP_OFF) + 2 * i;
    const unsigned lo = __builtin_amdgcn_readfirstlane(t[0]), hi = __builtin_amdgcn_readfirstlane(t[1]);
    return (const float*)(((unsigned long long)hi << 32) | lo);
}
__device__ __forceinline__ bf16* XB_(const Frame& F) { return (bf16*)(F.ws + WS_XB); }
__device__ __forceinline__ bf16* PROJ_(const Frame& F) { return (bf16*)(F.ws + WS_PROJ); }
__device__ __forceinline__ bf16* DNC_(const Frame& F) { return (bf16*)(F.ws + WS_DNC); }
__device__ __forceinline__ bf16* YS5_(const Frame& F) { return (bf16*)(F.ws + WS_YS5); }
__device__ __forceinline__ float* SSQ_(const Frame& F) { return (float*)(F.ws + WS_SSQ); }
__device__ __forceinline__ float* DG_(const Frame& F) { return (float*)(F.ws + WS_DG); }
__device__ __forceinline__ float* BIAS_(const Frame& F) { return (float*)(F.ws + WS_BIAS); }
__device__ __forceinline__ gu32* CTL_(const Frame& F) { return (gu32*)(F.ws + WS_CTL); }
__device__ __forceinline__ unsigned char* lw(const Frame& F, int l) { return F.ws + WS_LW + (size_t)l * LW_SIZE; }

__device__ __forceinline__ void tr_item(const float* W, int ld, int srccol0, int nvalid, const float* scale, int k0, bf16* dst, int n0, int Kd, LAS float* scr, int lane) {
    const int nn = lane & 31; const bool ok = nn < nvalid;
#pragma unroll 8
    for (int i = 0; i < 32; ++i) { const int kk = 2 * i + (lane >> 5); float v = 0.f;
        if (ok) { v = W[(size_t)(k0 + kk) * ld + srccol0 + nn]; if (scale) v *= scale[k0 + kk]; }
        scr[kk * 33 + nn] = v; }
    WAVE_FENCE();
    const int c = lane & 7;
#pragma unroll
    for (int j = 0; j < 4; ++j) { const int n = (lane >> 3) + 8 * j; const LAS float* s = scr + (8 * c) * 33 + n;
        u32x4 o; o.x = pk2(s[0 * 33], s[1 * 33]); o.y = pk2(s[2 * 33], s[3 * 33]); o.z = pk2(s[4 * 33], s[5 * 33]); o.w = pk2(s[6 * 33], s[7 * 33]);
        *(u32x4*)(dst + (size_t)(n0 + n) * Kd + k0 + 8 * c) = o; }
    WAVE_FENCE();
}
__device__ __forceinline__ bool win_map(int n0, int& src, int& nvalid) {
    nvalid = 32;
    if (n0 < 256) { src = n0; return true; }
    if (n0 < 512) { src = 416 + (n0 - 256); return true; }
    if (n0 < 768) { src = 672 + (n0 - 512); return true; }
    if (n0 < 1024) { src = 2216 + (n0 - 768); return true; }
    if (n0 < 1280) { src = 928 + (n0 - 1024); return true; }
    if (n0 < 1536) { src = 1184 + (n0 - 1280); return true; }
    if (n0 < 2432) return false;
    if (n0 < 2560) { src = 256 + (n0 - 2432); return true; }
    if (n0 < 3328) { src = 1440 + (n0 - 2560); return true; }
    if (n0 < 3360) { src = 384 + (n0 - 3328); return true; }
    if (n0 < 3392) { src = 2208; nvalid = 8; return true; }
    src = 0; nvalid = 0; return true;
}
__device__ __forceinline__ void p0_prologue(Frame& F) {
    LAS float* scr = (LAS float*)(F.lds + F.wave * WSCR);
    const int gw = F.vcu * NWAVES + F.wave, NGW = F.G * NWAVES, lane = F.lane;
    constexpr int I_WIN = (PP / 32) * (DM / 64), I_WOUT = (DM / 32) * (DM / 64), I_W13 = (2 * FFH / 32) * (DM / 64), I_W2 = (DM / 32) * (FFH / 64), I_GLU = (512 / 32) * (256 / 64);
    constexpr int I_L = I_WIN + I_WOUT + I_W13 + I_W2 + I_GLU;
    for (int it = gw; it < NL * I_L; it += NGW) {
        const int l = it / I_L; int r = it % I_L; unsigned char* L = lw(F, l);
        if (r < I_WIN) { const int nb = r / (DM / 64), kb = r % (DM / 64); int src, nv; if (!win_map(32 * nb, src, nv)) continue;
            tr_item(inp(F, 2) + (size_t)l * DM * INC, INC, src, nv, inp(F, 1) + l * DM, 64 * kb, (bf16*)(L + LW_WIN), 32 * nb, DM, scr, lane); continue; }
        r -= I_WIN;
        if (r < I_WOUT) { const int nb = r / (DM / 64), kb = r % (DM / 64);
            tr_item(inp(F, 3) + (size_t)l * DM * DM, DM, 32 * nb, 32, nullptr, 64 * kb, (bf16*)(L + LW_WOUT), 32 * nb, DM, scr, lane); continue; }
        r -= I_WOUT;
        if (r < I_W13) { const int nb = r / (DM / 64), kb = r % (DM / 64); const int n0 = 32 * nb, t = n0 >> 8, i = n0 & 255;
            const float* W = (i < 128 ? inp(F, 27) : inp(F, 28)) + (size_t)l * DM * FFH;
            tr_item(W, FFH, 128 * t + (i & 127), 32, inp(F, 26) + l * DM, 64 * kb, (bf16*)(L + LW_W13), n0, DM, scr, lane); continue; }
        r -= I_W13;
        if (r < I_W2) { const int nb = r / (FFH / 64), kb = r % (FFH / 64);
            tr_item(inp(F, 29) + (size_t)l * FFH * DM, DM, 32 * nb, 32, nullptr, 64 * kb, (bf16*)(L + LW_W2), 32 * nb, FFH, scr, lane); continue; }
        r -= I_W2;
        { const int nb = r / 4, kb = r % 4; const int n0 = 32 * nb, t = n0 >> 8, i = n0 & 255;
            tr_item(inp(F, 18) + (size_t)l * 256 * 512, 512, (i < 128 ? 0 : 256) + 128 * t + (i & 127), 32, nullptr, 64 * kb, (bf16*)(L + LW_WGLU), n0, 256, scr, lane); }
    }
    for (int it = gw; it < NL * DM * 14; it += NGW) {
        const int l = it / (DM * 14), r = it % (DM * 14), k = r / 14, ch = r % 14;
        const float* wrow = inp(F, 2) + (size_t)l * DM * INC + (size_t)k * INC; const float gk = inp(F, 1)[l * DM + k];
        bf16* WT = (bf16*)(lw(F, l) + LW_WIN);
        if (ch < 6) { const int n = 64 * ch + lane; const float* wu = inp(F, 6) + (size_t)l * 256 * 384 + n; const float* gn = inp(F, 4) + l * 256;
            float wv[4];
#pragma unroll
            for (int jj = 0; jj < 4; ++jj) wv[jj] = wrow[64 * jj + lane] * gn[64 * jj + lane];
            float acc = 0.f;
#pragma unroll
            for (int jj = 0; jj < 4; ++jj)
#pragma unroll 16
                for (int j = 0; j < 64; ++j) acc += __shfl(wv[jj], j) * wu[(size_t)(64 * jj + j) * 384];
            WT[(size_t)(C_MQ + n) * DM + k] = (bf16)f2bf(acc * gk);
        } else { const int n = 64 * (ch - 6) + lane; const float* wu = inp(F, 7) + (size_t)l * 128 * 512 + n; const float* gn = inp(F, 5) + l * 128;
            float wv[2];
#pragma unroll
            for (int jj = 0; jj < 2; ++jj) wv[jj] = wrow[256 + 64 * jj + lane] * gn[64 * jj + lane];
            float acc = 0.f;
#pragma unroll
            for (int jj = 0; jj < 2; ++jj)
#pragma unroll 16
                for (int j = 0; j < 64; ++j) acc += __shfl(wv[jj], j) * wu[(size_t)(64 * jj + j) * 512];
            WT[(size_t)(C_MKV + n) * DM + k] = (bf16)f2bf(acc * gk);
        }
    }
    for (int m = gw; m < TOK; m += NGW) {
        const f32x4* xr = (const f32x4*)(inp(F, 0) + (size_t)m * DM) + lane; float s = 0.f; u32x2* o8 = (u32x2*)(XB_(F) + (size_t)m * DM) + lane;
#pragma unroll
        for (int j = 0; j < 4; ++j) { const f32x4 v = xr[64 * j]; s += (v[0] * v[0] + v[1] * v[1]) + (v[2] * v[2] + v[3] * v[3]); u32x2 w; w.x = pk2(v[0], v[1]); w.y = pk2(v[2], v[3]); o8[64 * j] = w; }
        s = wave_sum(s);
        if (lane < 16) SSQ_(F)[(size_t)m * 16 + lane] = (lane == 0) ? s : 0.f;
    }
    for (int it = gw; it < NL * 16; it += NGW) {
        const int l = it / 16, g = it % 16, p = lane; const int gi = l * 16 + g;
        const double lr = inp(F, 10)[gi * 64 + p], li = inp(F, 11)[gi * 64 + p], dt = exp((double)inp(F, 12)[gi]);
        const double mag = exp(lr * dt), ar = mag * cos(li * dt), ai = mag * sin(li * dt), den = lr * lr + li * li, nr = ar - 1.0, ni = ai;
        const double zr = (nr * lr + ni * li) / den, zi = (ni * lr - nr * li) / den;
        float* AB = (float*)(lw(F, l) + LW_AB) + (g * 64 + p) * 2; AB[0] = (float)ar; AB[1] = (float)ai;
        float* BB = (float*)(lw(F, l) + LW_BB) + (size_t)(g * 64 + p) * 32;
        for (int c = 0; c < 16; ++c) { const double br = inp(F, 13)[((size_t)gi * 64 + p) * 16 + c], bi = inp(F, 14)[((size_t)gi * 64 + p) * 16 + c];
            BB[2 * c] = (float)(zr * br - zi * bi); BB[2 * c + 1] = (float)(zr * bi + zi * br); }
    }
    if (gw == 0) {
        for (int e = lane; e < 3 * 129; e += 64) { const int br = e / 129, delta = e % 129, dil = (br == 0) ? 1 : (br == 1 ? 4 : 16); const int dist = delta * dil;
            int bk; if (dist < 16) bk = dist; else { const float df = (float)dist; int lg = 16 + (int)(logf(df / 16.0f) / logf(128.0f) * 16.0f); bk = lg < 31 ? lg : 31; }
            for (int h = 0; h < 4; ++h) BIAS_(F)[e * 4 + h] = inp(F, 21)[bk * 4 + h] * LOG2E; }
    }
}

__device__ __forceinline__ void prep_token(Frame& F, int l, int t) {
    const int lane = F.lane, hh = lane >> 4, ii = lane & 15, s = t & (SEQ - 1);
    bf16* row = PROJ_(F) + (size_t)t * PP;
    float rs_q, rs_kv;
    { const u32x2 cq = *(const u32x2*)(row + C_CQ + 4 * lane); const float a = bf_lo(cq.x), b = bf_hi(cq.x), c = bf_lo(cq.y), d = bf_hi(cq.y);
      rs_q = 1.0f / sqrtf(wave_sum((a * a + b * b) + (c * c + d * d)) * (1.0f / 256.0f) + EPS);
      const unsigned ck = *(const unsigned*)(row + C_CKV + 2 * lane); const float e = bf_lo(ck), f = bf_hi(ck);
      rs_kv = 1.0f / sqrtf(wave_sum(e * e + f * f) * (1.0f / 128.0f) + EPS); }
    const float freq = exp2f(-(float)ii * (13.287712379549449f / 16.0f));
    float cs, sn; sincosf((float)s * freq, &sn, &cs);
    {
      bf16* qp = row + C_MQ + hh * 96; const u32x2 qn = *(const u32x2*)(qp + 4 * ii);
      float q0 = bf_lo(qn.x) * rs_q, q1 = bf_hi(qn.x) * rs_q, q2 = bf_lo(qn.y) * rs_q, q3 = bf_hi(qn.y) * rs_q, x1 = bf2f(qp[64 + ii]) * rs_q, x2 = bf2f(qp[80 + ii]) * rs_q;
      const float ss = grp16_sum((q0 * q0 + q1 * q1) + (q2 * q2 + q3 * q3) + (x1 * x1 + x2 * x2));
      const float* gq = inp(F, 8) + l * 96; const float rn = (1.0f / sqrtf(ss * (1.0f / 96.0f) + EPS)) * (0.10206207261596577f * LOG2E);
      q0 *= rn * gq[4 * ii]; q1 *= rn * gq[4 * ii + 1]; q2 *= rn * gq[4 * ii + 2]; q3 *= rn * gq[4 * ii + 3]; x1 *= rn * gq[64 + ii]; x2 *= rn * gq[80 + ii];
      u32x2 w; w.x = pk2(q0, q1); w.y = pk2(q2, q3); *(u32x2*)(qp + 4 * ii) = w;
      qp[64 + ii] = (bf16)f2bf(x1 * cs - x2 * sn); qp[80 + ii] = (bf16)f2bf(x1 * sn + x2 * cs); }
    {
      bf16* kp = row + C_MKV + hh * 128; const u32x2 kn = *(const u32x2*)(kp + 4 * ii); const u32x2 vv = *(const u32x2*)(kp + 64 + 4 * ii);
      float k0 = bf_lo(kn.x) * rs_kv, k1 = bf_hi(kn.x) * rs_kv, k2 = bf_lo(kn.y) * rs_kv, k3 = bf_hi(kn.y) * rs_kv, x1 = bf2f(row[C_KR + ii]), x2 = bf2f(row[C_KR + 16 + ii]);
      const float ss = grp16_sum((k0 * k0 + k1 * k1) + (k2 * k2 + k3 * k3) + (x1 * x1 + x2 * x2));
      const float* gk = inp(F, 9) + l * 96; const float rn = 1.0f / sqrtf(ss * (1.0f / 96.0f) + EPS);
      k0 *= rn * gk[4 * ii]; k1 *= rn * gk[4 * ii + 1]; k2 *= rn * gk[4 * ii + 2]; k3 *= rn * gk[4 * ii + 3]; x1 *= rn * gk[64 + ii]; x2 *= rn * gk[80 + ii];
      u32x2 w; w.x = pk2(k0, k1); w.y = pk2(k2, k3); *(u32x2*)(kp + 4 * ii) = w;
      u32x2 wv; wv.x = pk2(bf_lo(vv.x) * rs_kv, bf_hi(vv.x) * rs_kv); wv.y = pk2(bf_lo(vv.y) * rs_kv, bf_hi(vv.y) * rs_kv); *(u32x2*)(kp + 64 + 4 * ii) = wv;
      bf16* rp = row + C_CKV + hh * 32; rp[ii] = (bf16)f2bf(x1 * cs - x2 * sn); rp[16 + ii] = (bf16)f2bf(x1 * sn + x2 * cs); }
    { bf16* qp = row + C_DQ + hh * 64 + 4 * ii; const u32x2 qn = *(const u32x2*)qp; float a = bf_lo(qn.x), b = bf_hi(qn.x), c = bf_lo(qn.y), d = bf_hi(qn.y);
      const float* g = inp(F, 19) + l * 64 + 4 * ii; const float rn = (1.0f / sqrtf(grp16_sum((a * a + b * b) + (c * c + d * d)) * (1.0f / 64.0f) + EPS)) * (0.125f * LOG2E);
      u32x2 w; w.x = pk2(a * rn * g[0], b * rn * g[1]); w.y = pk2(c * rn * g[2], d * rn * g[3]); *(u32x2*)qp = w; }
    { bf16* kp = row + C_DK + hh * 64 + 4 * ii; const u32x2 kn = *(const u32x2*)kp; float a = bf_lo(kn.x), b = bf_hi(kn.x), c = bf_lo(kn.y), d = bf_hi(kn.y);
      const float* g = inp(F, 20) + l * 64 + 4 * ii; const float rn = 1.0f / sqrtf(grp16_sum((a * a + b * b) + (c * c + d * d)) * (1.0f / 64.0f) + EPS);
      u32x2 w; w.x = pk2(a * rn * g[0], b * rn * g[1]); w.y = pk2(c * rn * g[2], d * rn * g[3]); *(u32x2*)kp = w; }
}

constexpr int VP = 144;
__device__ __forceinline__ s16x4 tr_read(const LAS unsigned char* p) {
    typedef short v4i16_t __attribute__((ext_vector_type(4)));
    return __builtin_bit_cast(s16x4, __builtin_amdgcn_ds_read_tr16_b64_v4i16((LAS v4i16_t*)p));
}
__device__ __forceinline__ unsigned cvtpk(float lo, float hi) { typedef float f2 __attribute__((ext_vector_type(2))); typedef __bf16 b2 __attribute__((ext_vector_type(2))); f2 v = {lo, hi}; return __builtin_bit_cast(unsigned, __builtin_convertvector(v, b2)); }
template <int NKS, class MB>
__device__ __forceinline__ void attn_core(const bf16x8 (&qf)[NKS], const bf16x8 (&kf)[2][NKS], const u32x4 (&vr)[4], const MB& mb, LAS unsigned char* vl, int lane, float& m, float& l, f32x4 (&o)[4]) {
    f32x4 s0 = {0.f, 0.f, 0.f, 0.f}, s1 = {0.f, 0.f, 0.f, 0.f};
#pragma unroll
    for (int ks = 0; ks < NKS; ++ks) { s0 = __builtin_amdgcn_mfma_f32_16x16x32_bf16(kf[0][ks], qf[ks], s0, 0, 0, 0); s1 = __builtin_amdgcn_mfma_f32_16x16x32_bf16(kf[1][ks], qf[ks], s1, 0, 0, 0); }
    mb(s0, s1);
    float mx = fmaxf(fmaxf(fmaxf(s0[0], s0[1]), fmaxf(s0[2], s0[3])), fmaxf(fmaxf(s1[0], s1[1]), fmaxf(s1[2], s1[3])));
    mx = fmaxf(mx, __shfl_xor(mx, 16)); mx = fmaxf(mx, __shfl_xor(mx, 32));
    const float mn = fmaxf(m, mx), alpha = __builtin_amdgcn_exp2f(m - mn); m = mn;
    float p0[4], p1[4], ps = 0.f;
#pragma unroll
    for (int i = 0; i < 4; ++i) { p0[i] = __builtin_amdgcn_exp2f(s0[i] - mn); p1[i] = __builtin_amdgcn_exp2f(s1[i] - mn); ps += p0[i] + p1[i]; }
    l = l * alpha + ps;
#pragma unroll
    for (int dt = 0; dt < 4; ++dt) o[dt] = o[dt] * alpha;
    WAVE_FENCE();
#pragma unroll
    for (int it = 0; it < 4; ++it) *(LAS u32x4*)(vl + ((lane >> 3) + 8 * it) * VP + (lane & 7) * 16) = vr[it];
    WAVE_FENCE();
    u32x4 pw; pw.x = cvtpk(p0[0], p0[1]); pw.y = cvtpk(p0[2], p0[3]); pw.z = cvtpk(p1[0], p1[1]); pw.w = cvtpk(p1[2], p1[3]);
    const bf16x8 pB = __builtin_bit_cast(bf16x8, pw);
    const int g = lane >> 4, i16 = lane & 15; const LAS unsigned char* vb = vl + (4 * g + (i16 >> 2)) * VP + (i16 & 3) * 8;
#pragma unroll
    for (int dt = 0; dt < 4; ++dt) { const s16x4 lo = tr_read(vb + dt * 32), hi = tr_read(vb + 16 * VP + dt * 32);
        const bf16x8 a = {lo[0], lo[1], lo[2], lo[3], hi[0], hi[1], hi[2], hi[3]};
        o[dt] = __builtin_amdgcn_mfma_f32_16x16x32_bf16(a, pB, o[dt], 0, 0, 0); }
    WAVE_FENCE();
}
struct MlaMask { int key0, qpos, q4;
    __device__ __forceinline__ void operator()(f32x4& s0, f32x4& s1) const {
#pragma unroll
        for (int i = 0; i < 4; ++i) { if (key0 + q4 + i > qpos) s0[i] = -INFINITY; if (key0 + 16 + q4 + i > qpos) s1[i] = -INFINITY; } } };
struct DilMask { int pq, kbase, q4, h; const LAS float* tbl;
    __device__ __forceinline__ void operator()(f32x4& s0, f32x4& s1) const {
#pragma unroll
        for (int i = 0; i < 4; ++i) {
            { const int pk = kbase + q4 + i, d = pq - pk; const int dc = d < 0 ? 0 : (d > 128 ? 128 : d); const float b = tbl[dc * 4 + h]; s0[i] = (d >= 0 && d <= 128 && pk >= 0) ? s0[i] + b : -INFINITY; }
            { const int pk = kbase + 16 + q4 + i, d = pq - pk; const int dc = d < 0 ? 0 : (d > 128 ? 128 : d); const float b = tbl[dc * 4 + h]; s1[i] = (d >= 0 && d <= 128 && pk >= 0) ? s1[i] + b : -INFINITY; } } } };

__device__ __forceinline__ void mla_item(Frame& F, int b, int h, int qt, LAS unsigned char* scr) {
    const int lane = F.lane, r = lane & 15, q = lane >> 4; const size_t rowbase = (size_t)b * SEQ; const int q0 = qt * 16;
    const bf16* P = PROJ_(F);
    bf16x8 qf[3];
    { const bf16* qp = P + (rowbase + q0 + r) * PP + C_MQ + h * 96 + 8 * q;
#pragma unroll
      for (int ks = 0; ks < 3; ++ks) qf[ks] = *(const bf16x8*)(qp + 32 * ks); }
    float m = -1e30f, l = 0.f; f32x4 o[4];
#pragma unroll
    for (int dt = 0; dt < 4; ++dt) o[dt] = (f32x4){0.f, 0.f, 0.f, 0.f};
    const int nst = (q0 + 15) / 32 + 1;
    for (int st = 0; st < nst; ++st) { const int key0 = 32 * st;
        bf16x8 kf[2][3]; u32x4 vr[4];
#pragma unroll
        for (int t = 0; t < 2; ++t) { const bf16* kr = P + (rowbase + key0 + 16 * t + r) * PP;
            kf[t][0] = *(const bf16x8*)(kr + C_MKV + h * 128 + 8 * q); kf[t][1] = *(const bf16x8*)(kr + C_MKV + h * 128 + 32 + 8 * q); kf[t][2] = *(const bf16x8*)(kr + C_CKV + h * 32 + 8 * q); }
#pragma unroll
        for (int it = 0; it < 4; ++it) vr[it] = *(const u32x4*)(P + (rowbase + key0 + (lane >> 3) + 8 * it) * PP + C_MKV + h * 128 + 64 + (lane & 7) * 8);
        const MlaMask mb{key0, q0 + r, 4 * q};
        attn_core<3, MlaMask>(qf, kf, vr, mb, scr, lane, m, l, o);
    }
    l += __shfl_xor(l, 16); l += __shfl_xor(l, 32); const float il = 1.0f / l;
    bf16* op = PROJ_(F) + (rowbase + q0 + r) * PP + C_CQ + h * 64 + 4 * q;
#pragma unroll
    for (int dt = 0; dt < 4; ++dt) { u32x2 w; w.x = pk2(o[dt][0] * il, o[dt][1] * il); w.y = pk2(o[dt][2] * il, o[dt][3] * il); *(u32x2*)(op + 16 * dt) = w; }
}
__device__ __forceinline__ void dil_item(Frame& F, int b, int h, int blk, int r16, LAS unsigned char* scr, const LAS float* tbl) {
    const int lane = F.lane, r = lane & 15, q = lane >> 4; const size_t rowbase = (size_t)b * SEQ; const int t0 = 256 * blk + r16;
    const bf16* P = PROJ_(F);
    bf16x8 qf[2];
    { const bf16* qp = P + (rowbase + t0 + 16 * r) * PP + C_DQ + h * 64 + 8 * q; qf[0] = *(const bf16x8*)qp; qf[1] = *(const bf16x8*)(qp + 32); }
    float m = -1e30f, l = 0.f; f32x4 o[4];
#pragma unroll
    for (int dt = 0; dt < 4; ++dt) o[dt] = (f32x4){0.f, 0.f, 0.f, 0.f};
    for (int br = 0; br < 3; ++br) {
        const int dil = (br == 0) ? 1 : (br == 1 ? 4 : 16), L = SEQ / dil, rd = t0 & (dil - 1), qstep = 16 / dil;
        const int pq0 = (t0 - rd) / dil;
        const int plo = pq0 - 128 < 0 ? 0 : pq0 - 128, phi = pq0 + qstep * 15;
        const int nst = (phi - plo) / 32 + 1;
        for (int st = 0; st < nst; ++st) { const int kb = plo + 32 * st;
            bf16x8 kf[2][2]; u32x4 vr[4];
#pragma unroll
            for (int t = 0; t < 2; ++t) { int pk = kb + 16 * t + r; pk = pk > L - 1 ? L - 1 : pk; const bf16* kr = P + (rowbase + rd + (size_t)dil * pk) * PP + C_DK + h * 64 + 8 * q;
                kf[t][0] = *(const bf16x8*)kr; kf[t][1] = *(const bf16x8*)(kr + 32); }
#pragma unroll
            for (int it = 0; it < 4; ++it) { int pk = kb + (lane >> 3) + 8 * it; pk = pk > L - 1 ? L - 1 : pk; vr[it] = *(const u32x4*)(P + (rowbase + rd + (size_t)dil * pk) * PP + C_DV + h * 64 + (lane & 7) * 8); }
            const DilMask mb{pq0 + qstep * r, kb, 4 * q, h, tbl + br * 129 * 4};
            attn_core<2, DilMask>(qf, kf, vr, mb, scr, lane, m, l, o);
        }
    }
    l += __shfl_xor(l, 16); l += __shfl_xor(l, 32); const float il = 1.0f / l;
    bf16* op = PROJ_(F) + (rowbase + t0 + 16 * r) * PP + C_DQ + h * 64 + 4 * q;
#pragma unroll
    for (int dt = 0; dt < 4; ++dt) { u32x2 w; w.x = pk2(o[dt][0] * il, o[dt][1] * il); w.y = pk2(o[dt][2] * il, o[dt][3] * il); *(u32x2*)(op + 16 * dt) = w; }
}
__device__ __forceinline__ void s5_item(Frame& F, int l, int b, int g, LAS unsigned char* scr) {
    const int lane = F.lane, r = lane & 15, q = lane >> 4, gi = l * 16 + g;
    LAS float* Ss = (LAS float*)scr;
    LAS bf16* Hs = (LAS bf16*)(scr + 8192);
    const float* AB = (const float*)(lw(F, l) + LW_AB) + (g * 64 + lane) * 2; const float ar = AB[0], ai = AB[1];
    bf16x8 Bfr[8], Cfr[4];
    { const float* BB = (const float*)(lw(F, l) + LW_BB);
#pragma unroll
      for (int nt = 0; nt < 8; ++nt) { const int n = 16 * nt + r, p = n >> 1, ri = n & 1; u32x4 w = {0u, 0u, 0u, 0u};
          if (q < 2) { const float* bp = BB + ((size_t)(g * 64 + p) * 16 + 8 * q) * 2 + ri;
              w.x = pk2(bp[0], bp[2]); w.y = pk2(bp[4], bp[6]); w.z = pk2(bp[8], bp[10]); w.w = pk2(bp[12], bp[14]); }
          Bfr[nt] = __builtin_bit_cast(bf16x8, w); }
      const float* cre = inp(F, 15) + ((size_t)gi * 16 + r) * 64; const float* cim = inp(F, 16) + ((size_t)gi * 16 + r) * 64;
#pragma unroll
      for (int ks = 0; ks < 4; ++ks) { const int p0 = 16 * ks + 4 * q;
          u32x4 w; w.x = pk2(cre[p0], -cim[p0]); w.y = pk2(cre[p0 + 1], -cim[p0 + 1]); w.z = pk2(cre[p0 + 2], -cim[p0 + 2]); w.w = pk2(cre[p0 + 3], -cim[p0 + 3]);
          Cfr[ks] = __builtin_bit_cast(bf16x8, w); } }
    const float dsk = inp(F, 17)[l * 256 + g * 16 + r];
    float hr = 0.f, hi = 0.f;
    const bf16* ub = PROJ_(F) + (size_t)b * SEQ * PP + C_US5 + g * 16;
    bf16* yb = YS5_(F) + (size_t)b * SEQ * 256 + g * 16 + r;
    for (int tt = 0; tt < SEQ / 16; ++tt) { const int t0 = 16 * tt;
        u32x4 aw = {0u, 0u, 0u, 0u}; if (q < 2) aw = *(const u32x4*)(ub + (size_t)(t0 + r) * PP + 8 * q);
        const bf16x8 A = __builtin_bit_cast(bf16x8, aw);
        float ud[4];
#pragma unroll
        for (int i = 0; i < 4; ++i) ud[i] = bf2f(ub[(size_t)(t0 + 4 * q + i) * PP + r]);
#pragma unroll
        for (int nt = 0; nt < 8; ++nt) { const f32x4 x = __builtin_amdgcn_mfma_f32_16x16x32_bf16(A, Bfr[nt], (f32x4){0.f, 0.f, 0.f, 0.f}, 0, 0, 0);
#pragma unroll
            for (int i = 0; i < 4; ++i) Ss[(4 * q + i) * 128 + 16 * nt + r] = x[i]; }
        WAVE_FENCE();
        typedef float f2 __attribute__((ext_vector_type(2)));
        f2 xs[16];
#pragma unroll
        for (int tk = 0; tk < 16; ++tk) xs[tk] = *(const LAS f2*)(Ss + tk * 128 + 2 * lane);
#pragma unroll
        for (int tk = 0; tk < 16; ++tk) { const float nr = ar * hr - ai * hi + xs[tk].x, ni = ar * hi + ai * hr + xs[tk].y; hr = nr; hi = ni;
            *(LAS unsigned*)(Hs + tk * 128 + 2 * lane) = cvtpk(hr, hi); }
        WAVE_FENCE();
        f32x4 y = {0.f, 0.f, 0.f, 0.f};
#pragma unroll
        for (int ks = 0; ks < 4; ++ks) y = __builtin_amdgcn_mfma_f32_16x16x32_bf16(*(const LAS bf16x8*)(Hs + r * 128 + 32 * ks + 8 * q), Cfr[ks], y, 0, 0, 0);
#pragma unroll
        for (int i = 0; i < 4; ++i) yb[(size_t)(t0 + 4 * q + i) * 256] = (bf16)f2bf(y[i] + dsk * ud[i]);
        WAVE_FENCE();
    }
}
constexpr int DN_NW = 0, DN_UT = 4096, DN_AQ = 8192, DN_QD = 12288, DN_KT = 16384, DN_CH = 20480;
__device__ __forceinline__ int pcol(int c) { return (c & 32) | (((c >> 2) & 3) << 3) | (((c >> 4) & 1) << 2) | (c & 3); }
__device__ __forceinline__ void dn_chunk_prep(Frame& F, int l, int c) {
    const int tid = F.tid, tok = tid >> 3, part = tid & 7, lane = F.lane, wave = F.wave;
    const int n = c & 31, bh = c >> 5, h = bh & 3, b = bh >> 2, s = 64 * n + tok;
    const size_t t0 = (size_t)b * SEQ + 64 * n;
    LAS bf16* Kb = (LAS bf16*)F.lds; LAS bf16* KBb = Kb + 64 * 72; LAS bf16* Qb = KBb + 64 * 72;
    LAS float* Lm = (LAS float*)(F.lds + 3 * 9216); LAS float* RH = Lm + 4096; LAS float* gcs = RH + 8192;
    bf16* CO = DNC_(F) + (size_t)c * DN_CH;
    float qkv[3][8];
    { const float* cw = inp(F, 22) + (size_t)l * 4 * 768 + h * 64 + 8 * part; const bf16* src = PROJ_(F) + (t0 + tok) * PP + C_DN + h * 64 + 8 * part;
#pragma unroll
      for (int w3 = 0; w3 < 3; ++w3) {
#pragma unroll
          for (int e = 0; e < 8; ++e) qkv[w3][e] = 0.f;
#pragma unroll
          for (int j = 0; j < 4; ++j) { if (s - 3 + j >= 0) { const u32x4 xv = *(const u32x4*)(src + (ptrdiff_t)(j - 3) * PP + w3 * 256); const f32x4 w0 = *(const f32x4*)(cw + j * 768 + w3 * 256), w1 = *(const f32x4*)(cw + j * 768 + w3 * 256 + 4);
              qkv[w3][0] += w0[0] * bf_lo(xv.x); qkv[w3][1] += w0[1] * bf_hi(xv.x); qkv[w3][2] += w0[2] * bf_lo(xv.y); qkv[w3][3] += w0[3] * bf_hi(xv.y);
              qkv[w3][4] += w1[0] * bf_lo(xv.z); qkv[w3][5] += w1[1] * bf_hi(xv.z); qkv[w3][6] += w1[2] * bf_lo(xv.w); qkv[w3][7] += w1[3] * bf_hi(xv.w); } }
          float ss = 0.f;
#pragma unroll
          for (int e = 0; e < 8; ++e) { qkv[w3][e] = silu_f(qkv[w3][e]); ss += qkv[w3][e] * qkv[w3][e]; }
          if (w3 < 2) { ss += __shfl_xor(ss, 1); ss += __shfl_xor(ss, 2); ss += __shfl_xor(ss, 4); const float sc = (1.0f / sqrtf(ss + EPS)) * (w3 == 0 ? 0.125f : 1.0f);
#pragma unroll
              for (int e = 0; e < 8; ++e) qkv[w3][e] *= sc; } }
      if (part == 0) { const bf16* row = PROJ_(F) + (t0 + tok) * PP; const float av = bf2f(row[C_A + h]), bv = bf2f(row[C_B + h]); const float xx = av + inp(F, 24)[l * 4 + h];
          const float sp = xx > 20.f ? xx : log1pf(expf(xx)); gcs[128 + tok] = -expf(inp(F, 23)[l * 4 + h]) * sp; gcs[64 + tok] = 1.0f / (1.0f + expf(-bv)); }
      u32x4 w; w.x = pk2(qkv[0][0], qkv[0][1]); w.y = pk2(qkv[0][2], qkv[0][3]); w.z = pk2(qkv[0][4], qkv[0][5]); w.w = pk2(qkv[0][6], qkv[0][7]); *(LAS u32x4*)(Qb + tok * 72 + 8 * part) = w;
      w.x = pk2(qkv[1][0], qkv[1][1]); w.y = pk2(qkv[1][2], qkv[1][3]); w.z = pk2(qkv[1][4], qkv[1][5]); w.w = pk2(qkv[1][6], qkv[1][7]); *(LAS u32x4*)(Kb + tok * 72 + 8 * part) = w; }
    __syncthreads();
    if (wave == 0) { float g = gcs[128 + lane];
#pragma unroll
        for (int o = 1; o < 64; o <<= 1) { const float t = __shfl_up(g, o); if (lane >= o) g += t; }
        gcs[lane] = g; }
    __syncthreads();
    { const float gc = gcs[tok], gl = gcs[63], beta = gcs[64 + tok], eg = __expf(gc), ek = __expf(gl - gc);
      float kb[8];
#pragma unroll
      for (int e = 0; e < 8; ++e) { kb[e] = qkv[1][e] * beta; RH[tok * 128 + 8 * part + e] = kb[e] * eg; RH[tok * 128 + 64 + 8 * part + e] = qkv[2][e] * beta; }
      u32x4 w; w.x = pk2(kb[0], kb[1]); w.y = pk2(kb[2], kb[3]); w.z = pk2(kb[4], kb[5]); w.w = pk2(kb[6], kb[7]); *(LAS u32x4*)(KBb + tok * 72 + 8 * part) = w;
      { bf16* qd = CO + DN_QD + tok * 64; u32x2 a, bq; a.x = pk2(qkv[0][0] * eg, qkv[0][1] * eg); a.y = pk2(qkv[0][2] * eg, qkv[0][3] * eg); bq.x = pk2(qkv[0][4] * eg, qkv[0][5] * eg); bq.y = pk2(qkv[0][6] * eg, qkv[0][7] * eg);
        *(u32x2*)(qd + pcol(8 * part)) = a; *(u32x2*)(qd + pcol(8 * part + 4)) = bq; }
#pragma unroll
      for (int e = 0; e < 8; ++e) CO[DN_KT + (8 * part + e) * 64 + pcol(tok)] = (bf16)f2bf(qkv[1][e] * ek);
      if (tid == 0) DG_(F)[c] = __expf(gl); }
    __syncthreads();
#pragma unroll
    for (int rep = 0; rep < 2; ++rep) { const int id = wave + 8 * rep, ti = id >> 2, tj = id & 3, r = lane & 15, q = lane >> 4;
        f32x4 kk = {0.f, 0.f, 0.f, 0.f}, qk = {0.f, 0.f, 0.f, 0.f};
        if (tj <= ti) {
#pragma unroll
            for (int ks = 0; ks < 2; ++ks) { const bf16x8 bk = *(const LAS bf16x8*)(Kb + (16 * tj + r) * 72 + 32 * ks + 8 * q);
                kk = __builtin_amdgcn_mfma_f32_16x16x32_bf16(*(const LAS bf16x8*)(KBb + (16 * ti + r) * 72 + 32 * ks + 8 * q), bk, kk, 0, 0, 0);
                qk = __builtin_amdgcn_mfma_f32_16x16x32_bf16(*(const LAS bf16x8*)(Qb + (16 * ti + r) * 72 + 32 * ks + 8 * q), bk, qk, 0, 0, 0); } }
        const int cj = 16 * tj + r; const float gj = gcs[cj];
#pragma unroll
        for (int e = 0; e < 4; ++e) { const int ri = 16 * ti + 4 * q + e; const float dec = __expf(fminf(gcs[ri] - gj, 0.f));
            Lm[ri * 64 + cj] = (cj < ri) ? kk[e] * dec : 0.f;
            CO[DN_AQ + ri * 64 + pcol(cj)] = (bf16)f2bf((cj <= ri) ? qk[e] * dec : 0.f); } }
    __syncthreads();
    if (tid < 128) { float x[64];
#pragma unroll
        for (int i = 0; i < 64; ++i) { float a0 = RH[i * 128 + tid], a1 = 0.f, a2 = 0.f, a3 = 0.f;
#pragma unroll
            for (int j4 = 0; j4 < (i + 3) / 4; ++j4) { const f32x4 lv = *(const LAS f32x4*)(Lm + i * 64 + 4 * j4);
                if (4 * j4 < i) a0 -= lv[0] * x[4 * j4]; if (4 * j4 + 1 < i) a1 -= lv[1] * x[4 * j4 + 1]; if (4 * j4 + 2 < i) a2 -= lv[2] * x[4 * j4 + 2]; if (4 * j4 + 3 < i) a3 -= lv[3] * x[4 * j4 + 3]; }
            x[i] = (a0 + a1) + (a2 + a3); }
        if (tid < 64) { const int pc = pcol(tid);
#pragma unroll
            for (int i = 0; i < 64; ++i) CO[DN_NW + i * 64 + pc] = (bf16)f2bf(-x[i]); }
        else { bf16* ut = CO + DN_UT + (tid - 64) * 64;
#pragma unroll
            for (int i8 = 0; i8 < 8; ++i8) { u32x4 w; w.x = pk2(x[8 * i8], x[8 * i8 + 1]); w.y = pk2(x[8 * i8 + 2], x[8 * i8 + 3]); w.z = pk2(x[8 * i8 + 4], x[8 * i8 + 5]); w.w = pk2(x[8 * i8 + 6], x[8 * i8 + 7]); *(u32x4*)(ut + 8 * i8) = w; } } }
    __syncthreads();
}
__device__ __forceinline__ bf16x8 pack8(const f32x4& a, const f32x4& b) { u32x4 w; w.x = cvtpk(a[0], a[1]); w.y = cvtpk(a[2], a[3]); w.z = cvtpk(b[0], b[1]); w.w = cvtpk(b[2], b[3]); return __builtin_bit_cast(bf16x8, w); }
__device__ __forceinline__ void dn_item(Frame& F, int l, int b, int h, int sl) {
    const int lane = F.lane, r = lane & 15, q = lane >> 4;
    f32x4 S[4];
#pragma unroll
    for (int t = 0; t < 4; ++t) S[t] = (f32x4){0.f, 0.f, 0.f, 0.f};
    const bf16* C0 = DNC_(F) + (size_t)((b * 4 + h) * 32) * DN_CH; const float* DGp = DG_(F) + (b * 4 + h) * 32;
    const int fo = r * 64 + 8 * q;
    bf16x8 NW[4][2], QD[4][2], AQ[4][2], KT[4][2]; u32x2 UT[4]; float dg;
#define DN_LD1(C) do { _Pragma("unroll") for (int m = 0; m < 4; ++m) { NW[m][0] = *(const bf16x8*)((C) + DN_NW + m * 1024 + fo); NW[m][1] = *(const bf16x8*)((C) + DN_NW + m * 1024 + fo + 32); \
        UT[m] = *(const u32x2*)((C) + DN_UT + (16 * sl + r) * 64 + 16 * m + 4 * q); } } while (0)
#define DN_LD2(C) do { _Pragma("unroll") for (int m = 0; m < 4; ++m) { QD[m][0] = *(const bf16x8*)((C) + DN_QD + m * 1024 + fo); QD[m][1] = *(const bf16x8*)((C) + DN_QD + m * 1024 + fo + 32); \
        AQ[m][0] = *(const bf16x8*)((C) + DN_AQ + m * 1024 + fo); AQ[m][1] = *(const bf16x8*)((C) + DN_AQ + m * 1024 + fo + 32); } } while (0)
#define DN_LD3(C, n_) do { _Pragma("unroll") for (int t = 0; t < 4; ++t) { KT[t][0] = *(const bf16x8*)((C) + DN_KT + t * 1024 + fo); KT[t][1] = *(const bf16x8*)((C) + DN_KT + t * 1024 + fo + 32); } dg = DGp[n_]; } while (0)
    DN_LD1(C0); DN_LD2(C0); DN_LD3(C0, 0);
    for (int n = 0; n < 32; ++n) { const int nn = n < 31 ? n + 1 : 31; const bf16* Cn = C0 + (size_t)nn * DN_CH; const size_t t0 = (size_t)b * SEQ + 64 * n;
        const bf16x8 Sb0 = pack8(S[0], S[1]), Sb1 = pack8(S[2], S[3]);
        f32x4 vn[4];
#pragma unroll
        for (int m = 0; m < 4; ++m) { f32x4 u = {bf_lo(UT[m].x), bf_hi(UT[m].x), bf_lo(UT[m].y), bf_hi(UT[m].y)};
            u = __builtin_amdgcn_mfma_f32_16x16x32_bf16(NW[m][0], Sb0, u, 0, 0, 0); vn[m] = __builtin_amdgcn_mfma_f32_16x16x32_bf16(NW[m][1], Sb1, u, 0, 0, 0); }
        const bf16x8 vb0 = pack8(vn[0], vn[1]), vb1 = pack8(vn[2], vn[3]);
        __builtin_amdgcn_sched_barrier(0);
        DN_LD1(Cn);
        __builtin_amdgcn_sched_barrier(0);
#pragma unroll
        for (int m = 0; m < 4; ++m) { f32x4 a = {0.f, 0.f, 0.f, 0.f};
            a = __builtin_amdgcn_mfma_f32_16x16x32_bf16(QD[m][0], Sb0, a, 0, 0, 0); a = __builtin_amdgcn_mfma_f32_16x16x32_bf16(QD[m][1], Sb1, a, 0, 0, 0);
            a = __builtin_amdgcn_mfma_f32_16x16x32_bf16(AQ[m][0], vb0, a, 0, 0, 0); if (m >= 2) a = __builtin_amdgcn_mfma_f32_16x16x32_bf16(AQ[m][1], vb1, a, 0, 0, 0);
#pragma unroll
            for (int i = 0; i < 4; ++i) { bf16* rowp = PROJ_(F) + (t0 + 16 * m + 4 * q + i) * PP + C_DN; rowp[h * 64 + 16 * sl + r] = (bf16)f2bf(a[i]);
                float v = a[i] * a[i]; v += __shfl_xor(v, 1); v += __shfl_xor(v, 2); v += __shfl_xor(v, 4); v += __shfl_xor(v, 8);
                if (r == 0) ((float*)(rowp + 256))[h * 4 + sl] = v; } }
        __builtin_amdgcn_sched_barrier(0);
        DN_LD2(Cn);
        __builtin_amdgcn_sched_barrier(0);
        const float dgc = dg;
#pragma unroll
        for (int t = 0; t < 4; ++t) { f32x4 a = S[t] * dgc; a = __builtin_amdgcn_mfma_f32_16x16x32_bf16(KT[t][0], vb0, a, 0, 0, 0); S[t] = __builtin_amdgcn_mfma_f32_16x16x32_bf16(KT[t][1], vb1, a, 0, 0, 0); }
        __builtin_amdgcn_sched_barrier(0);
        DN_LD3(Cn, nn);
        __builtin_amdgcn_sched_barrier(0);
    }
#undef DN_LD1
#undef DN_LD2
#undef DN_LD3
}
__device__ __forceinline__ void dn_finish(Frame& F, int l, int t) {
    const int lane = F.lane, hh = lane >> 4, ii = lane & 15;
    bf16* row = PROJ_(F) + (size_t)t * PP;
    const u32x2 ov = *(const u32x2*)(row + C_DN + hh * 64 + 4 * ii), gv = *(const u32x2*)(row + C_GATE + hh * 64 + 4 * ii);
    const f32x4 ss = *(const f32x4*)((const float*)(row + C_DN + 256) + hh * 4), on = *(const f32x4*)(inp(F, 25) + l * 64 + 4 * ii);
    const float rn = 1.0f / sqrtf(((ss[0] + ss[1]) + (ss[2] + ss[3])) * (1.0f / 64.0f) + EPS);
    u32x2 w; w.x = pk2(bf_lo(ov.x) * rn * on[0] * silu_f(bf_lo(gv.x)), bf_hi(ov.x) * rn * on[1] * silu_f(bf_hi(gv.x))); w.y = pk2(bf_lo(ov.y) * rn * on[2] * silu_f(bf_lo(gv.y)), bf_hi(ov.y) * rn * on[3] * silu_f(bf_hi(gv.y)));
    *(u32x2*)(row + C_GATE + hh * 64 + 4 * ii) = w;
}
constexpr int N_DN = 128, N_S5 = 128, N_ATT = 4096, N_ITEMS = N_DN + N_S5 + 2 * N_ATT;
__device__ __forceinline__ void mixer_phase(Frame& F, int l) {
    LAS unsigned char* scr = F.lds + F.wave * WSCR; LAS float* tbl = (LAS float*)(F.lds + TBL_OFF);
    for (int e = F.tid; e < 3 * 129 * 4; e += NWAVES * 64) tbl[e] = BIAS_(F)[e];
    __syncthreads();
    gu32* head = CTL_(F) + CW_Q + 64 * l;
    for (;;) {
        int idx = 0; if (F.lane == 0) idx = (int)__hip_atomic_fetch_add(head, 1u, RLX_AGENT);
        idx = __builtin_amdgcn_readfirstlane(idx);
        if (idx >= N_ITEMS) break;
        if (idx < N_DN) { if (PH_MASK & 256) dn_item(F, l, idx >> 4, (idx >> 2) & 3, idx & 3); continue; }
        idx -= N_DN;
        if (idx < N_S5) { if (PH_MASK & 512) for (int rp = 0; rp < REP_S5; ++rp) s5_item(F, l, idx >> 4, idx & 15, scr); continue; }
        idx -= N_S5;
        const int j = idx >> 1;
        if ((idx & 1) == 0) { const int bh = j & 31, qt = 127 - (j >> 5); if (PH_MASK & 1024) for (int rp = 0; rp < REP_MLA; ++rp) mla_item(F, bh >> 2, bh & 3, qt, scr); }
        else { const int bh = j & 31, rest = j >> 5; if (PH_MASK & 2048) dil_item(F, bh >> 2, bh & 3, 7 - (rest >> 4), rest & 15, scr, tbl); }
    }
}

constexpr int N_PHASES = 1 + 7 * NL;
struct Args { const float* in[30]; float* out; unsigned char* ws; int ph_lo, ph_hi; };
__global__ void __launch_bounds__(NWAVES * 64, 2) fwd_megakernel(Args args) {
    extern __shared__ __attribute__((aligned(16))) unsigned char lds[];
    Frame F;
    F.lds = (LAS unsigned char*)lds;
    F.tid = threadIdx.x; F.lane = F.tid & 63; F.wave = __builtin_amdgcn_readfirstlane(F.tid >> 6);
    F.G = gridDim.x; { const int bx = blockIdx.x; F.vcu = (F.G % 8 == 0) ? (bx % 8) * (F.G / 8) + bx / 8 : bx; }
    F.out = args.out; F.ws = args.ws;
    if (F.tid < 30) { const unsigned long long p = (unsigned long long)args.in[F.tid]; ((LAS unsigned*)(F.lds + INP_OFF))[2 * F.tid] = (unsigned)p; ((LAS unsigned*)(F.lds + INP_OFF))[2 * F.tid + 1] = (unsigned)(p >> 32); }
    volatile LAS unsigned* MISC = (volatile LAS unsigned*)(F.lds + MISC_OFF);
    if (F.tid < 64) MISC[F.tid] = 0u;
    __syncthreads();
#if MK_MODE == 1
    cooperative_groups::grid_group grid = cooperative_groups::this_grid();
#define GRID_BAR() grid.sync()
#elif MK_MODE == 2
    XcdBarrier bar = xcd_barrier_post((unsigned*)(CTL_(F) + CW_BAR), MISC + 8);
#define GRID_BAR() xcd_barrier(bar)
#else
#define GRID_BAR() do {} while (0)
#endif
    const int lo = args.ph_lo, hi = args.ph_hi;
#define IN(p) (lo <= (p) && (p) < hi)
#define REFRESH() do { int tv = threadIdx.x; asm volatile("" : "+v"(tv)); F.tid = tv; F.lane = tv & 63; F.wave = __builtin_amdgcn_readfirstlane(tv >> 6); \
        unsigned long long wv = (unsigned long long)args.ws, ov = (unsigned long long)args.out; asm volatile("" : "+s"(wv), "+s"(ov)); F.ws = (unsigned char*)wv; F.out = (float*)ov; } while (0)
#define SEAM(p) do { if (IN(p) && IN((p) + 1)) GRID_BAR(); } while (0)
    if (IN(0)) { REFRESH(); if (PH_MASK & 1) for (int rp = 0; rp < REP_PRO; ++rp) p0_prologue(F); }
    SEAM(0);
#define LAYER(l) do { \
    if (IN(1 + 7 * (l)) && (PH_MASK & 2)) { REFRESH(); unsigned char* L = lw(F, l); \
        pg8::Gemm g{XB_(F), (const bf16*)(L + LW_WIN), TOK, PP, DM, DM}; pg8::StaticOrder S; S.init(TOK, PP, F.G, (int)blockIdx.x); \
        pg8::EpiRowScale E{PROJ_(F), PP, SSQ_(F) + (size_t)(2 * (l)) * TOK * 16}; \
        for (int rp = 0; rp < REP_GEMM; ++rp) pg8::gemm_phase<pg8::EpiRowScale, pg8::StaticOrder, true, true>(F.lds, g, S, E); } \
    SEAM(1 + 7 * (l)); \
    if (IN(2 + 7 * (l)) && (PH_MASK & 4)) { REFRESH(); const int gw = F.vcu * NWAVES + F.wave, NGW = F.G * NWAVES; for (int t = gw; t < TOK; t += NGW) prep_token(F, l, t); \
        __syncthreads(); for (int rp = 0; rp < REP_DNP; ++rp) for (int c = (int)blockIdx.x; c < 1024; c += F.G) dn_chunk_prep(F, l, c); } \
    SEAM(2 + 7 * (l)); \
    if (IN(3 + 7 * (l)) && (PH_MASK & 8)) { REFRESH(); mixer_phase(F, l); } \
    SEAM(3 + 7 * (l)); \
    if (IN(4 + 7 * (l)) && (PH_MASK & 16)) { REFRESH(); unsigned char* L = lw(F, l); \
        { const int gw = F.vcu * NWAVES + F.wave, NGW = F.G * NWAVES; for (int t = gw; t < TOK; t += NGW) dn_finish(F, l, t); } \
        pg8::Gemm g{YS5_(F), (const bf16*)(L + LW_WGLU), TOK, 512, 256, 256}; pg8::StaticOrder S; S.init(TOK, 512, F.G, (int)blockIdx.x); \
        pg8::EpiGated<1> E{PROJ_(F) + C_US5, PP, nullptr}; \
        for (int rp = 0; rp < REP_GEMM; ++rp) pg8::gemm_phase<pg8::EpiGated<1>, pg8::StaticOrder, true, true>(F.lds, g, S, E); } \
    SEAM(4 + 7 * (l)); \
    if (IN(5 + 7 * (l)) && (PH_MASK & 32)) { REFRESH(); unsigned char* L = lw(F, l); \
        pg8::Gemm g{PROJ_(F), (const bf16*)(L + LW_WOUT), TOK, DM, DM, PP}; pg8::StaticOrder S; S.init(TOK, DM, F.G, (int)blockIdx.x); \
        pg8::EpiResid E{(l) == 0 ? inp(F, 0) : F.out, F.out, XB_(F), SSQ_(F) + (size_t)(2 * (l) + 1) * TOK * 16, 0}; \
        for (int rp = 0; rp < REP_GEMM; ++rp) { E.dry = (rp + 1 < REP_GEMM); pg8::gemm_phase<pg8::EpiResid, pg8::StaticOrder, true, true>(F.lds, g, S, E); } } \
    SEAM(5 + 7 * (l)); \
    if (IN(6 + 7 * (l)) && (PH_MASK & 64)) { REFRESH(); unsigned char* L = lw(F, l); \
        pg8::Gemm g{XB_(F), (const bf16*)(L + LW_W13), TOK, 2 * FFH, DM, DM}; pg8::StaticOrder S; S.init(TOK, 2 * FFH, F.G, (int)blockIdx.x); \
        pg8::EpiGated<0> E{PROJ_(F), FFH, SSQ_(F) + (size_t)(2 * (l) + 1) * TOK * 16}; \
        for (int rp = 0; rp < REP_GEMM; ++rp) pg8::gemm_phase<pg8::EpiGated<0>, pg8::StaticOrder, true, true>(F.lds, g, S, E); } \
    SEAM(6 + 7 * (l)); \
    if (IN(7 + 7 * (l)) && (PH_MASK & 128)) { REFRESH(); unsigned char* L = lw(F, l); \
        pg8::Gemm g{PROJ_(F), (const bf16*)(L + LW_W2), TOK, DM, FFH, FFH}; pg8::StaticOrder S; S.init(TOK, DM, F.G, (int)blockIdx.x); \
        pg8::EpiResid E{F.out, F.out, XB_(F), SSQ_(F) + (size_t)(2 * (l) + 2) * TOK * 16, 0}; \
        for (int rp = 0; rp < REP_GEMM; ++rp) { E.dry = (rp + 1 < REP_GEMM); pg8::gemm_phase<pg8::EpiResid, pg8::StaticOrder, true, true>(F.lds, g, S, E); } } \
    SEAM(7 + 7 * (l)); } while (0)
    LAYER(0);
    LAYER(1);
}

extern "C" void kernel_launch(void* const* d_in, const int* in_sizes, int n_in, void* d_out, int out_size, void* d_ws, size_t ws_size, hipStream_t stream) {
    static int grid = 0;
    if (grid == 0) {
        if (n_in != 30 || in_sizes[0] != TOK * DM || out_size != TOK * DM || ws_size < WS_END) {
            fprintf(stderr, "kernel_launch: unexpected shapes: n_in %d in0 %d out %d ws %zu (need %zu); nothing launched\n", n_in, n_in > 0 ? in_sizes[0] : -1, out_size, ws_size, (size_t)WS_END); grid = -1; return; }
        int dev = 0, cus = 0, per_cu = 0;
        if (hipGetDevice(&dev) != hipSuccess || hipDeviceGetAttribute(&cus, hipDeviceAttributeMultiprocessorCount, dev) != hipSuccess) { fprintf(stderr, "kernel_launch: device query failed\n"); grid = -1; return; }
        if (hipFuncSetAttribute((const void*)fwd_megakernel, hipFuncAttributeMaxDynamicSharedMemorySize, LDS_BYTES) != hipSuccess) { fprintf(stderr, "kernel_launch: hipFuncSetAttribute failed\n"); grid = -1; return; }
        if (hipOccupancyMaxActiveBlocksPerMultiprocessor(&per_cu, (const void*)fwd_megakernel, NWAVES * 64, LDS_BYTES) != hipSuccess || per_cu < 1) {
            fprintf(stderr, "kernel_launch: occupancy query reports %d workgroups per CU; nothing launched\n", per_cu); (void)hipGetLastError(); grid = -1; return; }
        grid = cus;
    }
    if (grid < 0) return;
    if (hipMemsetAsync((char*)d_ws + WS_CTL, 0, CTL_ZERO_BYTES, stream) != hipSuccess) { fprintf(stderr, "kernel_launch: memset failed\n"); return; }
    Args a{};
    for (int i = 0; i < 30; ++i) a.in[i] = (const float*)d_in[i];
    a.out = (float*)d_out; a.ws = (unsigned char*)d_ws;
#if MK_MODE == 0
    for (int p = 0; p < N_PHASES; ++p) { a.ph_lo = p; a.ph_hi = p + 1; hipLaunchKernelGGL(fwd_megakernel, dim3(grid), dim3(NWAVES * 64), LDS_BYTES, stream, a); }
#elif MK_MODE == 1
    a.ph_lo = 0; a.ph_hi = N_PHASES; void* kargs[] = {&a};
    hipError_t e = hipLaunchCooperativeKernel((const void*)fwd_megakernel, dim3(grid), dim3(NWAVES * 64), kargs, LDS_BYTES, stream);
    if (e != hipSuccess) fprintf(stderr, "kernel_launch: cooperative launch failed: %s (grid %d)\n", hipGetErrorString(e), grid);
#else
    a.ph_lo = 0; a.ph_hi = N_PHASES;
    hipLaunchKernelGGL(fwd_megakernel, dim3(grid), dim3(NWAVES * 64), LDS_BYTES, stream, a);
#endif
    const hipError_t le = hipPeekAtLastError();
    if (le != hipSuccess) fprintf(stderr, "kernel_launch: launch failed: %s\n", hipGetErrorName(le));
}
```
